# Optimizing an MI355X kernel written in HIP

```python
import jax, jax.numpy as jnp
from jax import lax
import numpy as np

D_MODEL = 2048
BATCH = 4
SEQ = 2048
DEPTH = 2

MEM_LEN = 256
HEAD_DIM = 128
CHUNK = 128
GMLP_WIDTH = D_MODEL // 2
POOL_WIDTH = D_MODEL // 4
CONV_WIDTH = D_MODEL - GMLP_WIDTH - POOL_WIDTH
MIX_WIDTH = GMLP_WIDTH + POOL_WIDTH + CONV_WIDTH
GMLP_HEADS = GMLP_WIDTH // HEAD_DIM
POOL_WINDOWS = (2, 4, 8, 16)
POOL_GROUPS = len(POOL_WINDOWS)
POOL_GROUP_WIDTH = POOL_WIDTH // POOL_GROUPS
MAX_WINDOW = max(POOL_WINDOWS)
CONV_K = 31
IN_COLS = 2 * GMLP_WIDTH + POOL_WIDTH + 2 * CONV_WIDTH
XATTN_HEADS = 4
XATTN_HEAD_DIM = D_MODEL // XATTN_HEADS
D_FF = 4 * D_MODEL
RMS_EPS = 1e-6
LN_EPS = 1e-5

kernel_name = "hybrid_gmlp_pool_conformer_block"


def rms_norm(x, g):
    xf = x.astype(jnp.float32)
    y = xf * lax.rsqrt(jnp.mean(xf * xf, axis=-1, keepdims=True) + RMS_EPS)
    return (y * g.astype(jnp.float32)).astype(x.dtype)


def layer_norm(x, g, b=None):
    xf = x.astype(jnp.float32)
    mu = jnp.mean(xf, axis=-1, keepdims=True)
    var = jnp.mean(jnp.square(xf - mu), axis=-1, keepdims=True)
    y = (xf - mu) * lax.rsqrt(var + LN_EPS) * g.astype(jnp.float32)
    if b is not None:
        y = y + b.astype(jnp.float32)
    return y.astype(x.dtype)


def spatial_gating(u, v, g_v, w_s, b_s):
    B, S, _ = u.shape
    u = u.reshape(B, S, GMLP_HEADS, HEAD_DIM)
    v = layer_norm(v.reshape(B, S, GMLP_HEADS, HEAD_DIM), g_v)
    mask = jnp.tril(jnp.ones((CHUNK, CHUNK), w_s.dtype))
    vc = v.reshape(B, S // CHUNK, CHUNK, GMLP_HEADS, HEAD_DIM)
    mixed = jnp.einsum('hts,bcshd->bcthd', w_s * mask, vc) + b_s.T[None, None, :, :, None]
    return (u * mixed.reshape(B, S, GMLP_HEADS, HEAD_DIM)).reshape(B, S, GMLP_WIDTH)


def multiscale_pool(p, w_pool, s_pool):
    B, S, _ = p.shape
    pf = p.astype(jnp.float32).reshape(B, S, POOL_GROUPS, POOL_GROUP_WIDTH)
    cs = jnp.cumsum(pf, axis=1)
    cs = jnp.pad(cs, ((0, 0), (MAX_WINDOW, 0), (0, 0), (0, 0)))
    pos = jnp.arange(S, dtype=jnp.float32)
    means = []
    for g, w in enumerate(POOL_WINDOWS):
        win = cs[:, MAX_WINDOW:, g] - cs[:, MAX_WINDOW - w:MAX_WINDOW - w + S, g]
        cnt = jnp.minimum(pos + 1.0, float(w))[None, :, None]
        means.append(win / cnt)
    pooled = jnp.stack(means, axis=2) - pf
    out = jnp.einsum('bsgc,gcd->bsgd', pooled, w_pool.astype(jnp.float32))
    out = out * s_pool.astype(jnp.float32).reshape(POOL_GROUPS, POOL_GROUP_WIDTH)
    return out.reshape(B, S, POOL_WIDTH).astype(p.dtype)


def conformer_conv(c_val, c_gate, w_dw, b_dw, ln_g, ln_b):
    h = c_val * jax.nn.sigmoid(c_gate)
    h = lax.conv_general_dilated(
        h, w_dw[:, None, :], window_strides=(1,), padding=[(CONV_K - 1, 0)],
        dimension_numbers=('NWC', 'WIO', 'NWC'), feature_group_count=CONV_WIDTH) + b_dw
    return jax.nn.silu(layer_norm(h, ln_g, ln_b))


def hybrid_mixer(h, w_in, w_out, g_v, w_s, b_s, w_pool, s_pool, w_dw, b_dw, ln_g, ln_b):
    z = h @ w_in
    cuts = (GMLP_WIDTH, 2 * GMLP_WIDTH, 2 * GMLP_WIDTH + POOL_WIDTH,
            2 * GMLP_WIDTH + POOL_WIDTH + CONV_WIDTH)
    z_a, p_b, c_val, c_gate = (z[..., :cuts[1]], z[..., cuts[1]:cuts[2]],
                               z[..., cuts[2]:cuts[3]], z[..., cuts[3]:])
    z_a = jax.nn.gelu(z_a)
    y_a = spatial_gating(z_a[..., :GMLP_WIDTH], z_a[..., GMLP_WIDTH:], g_v, w_s, b_s)
    y_b = multiscale_pool(p_b, w_pool, s_pool)
    y_c = conformer_conv(c_val, c_gate, w_dw, b_dw, ln_g, ln_b)
    return jnp.concatenate([y_a, y_b, y_c], axis=-1) @ w_out


def cross_attention(h, m, w_q, w_k, w_v, w_o):
    B, S, _ = h.shape
    q = (h @ w_q).reshape(B, S, XATTN_HEADS, XATTN_HEAD_DIM)
    k = (m @ w_k).reshape(B, MEM_LEN, XATTN_HEADS, XATTN_HEAD_DIM)
    v = (m @ w_v).reshape(B, MEM_LEN, XATTN_HEADS, XATTN_HEAD_DIM)
    scores = jnp.einsum('bshd,bmhd->bhsm', q.astype(jnp.float32), k.astype(jnp.float32))
    probs = jax.nn.softmax(scores * (XATTN_HEAD_DIM ** -0.5), axis=-1).astype(v.dtype)
    out = jnp.einsum('bhsm,bmhd->bshd', probs, v).reshape(B, S, D_MODEL)
    return out @ w_o


def setup_inputs(seed: int = 0) -> dict:
    key = jax.random.key(seed)
    ks = iter(jax.random.split(key, 32))
    f32 = jnp.float32

    def nrm(shape, scale):
        return jax.random.normal(next(ks), shape, f32) * scale

    def gain(shape):
        return 1.0 + 0.05 * jax.random.normal(next(ks), shape, f32)

    L = DEPTH
    return {
        "x": jax.random.normal(next(ks), (BATCH, SEQ, D_MODEL), f32),
        "mem": jax.random.normal(next(ks), (BATCH, MEM_LEN, D_MODEL), f32),
        "norm_mix_pre": gain((L, D_MODEL)),
        "norm_mix_post": gain((L, D_MODEL)),
        "w_in": nrm((L, D_MODEL, IN_COLS), D_MODEL ** -0.5),
        "w_out": nrm((L, MIX_WIDTH, D_MODEL), MIX_WIDTH ** -0.5),
        "gmlp_v_gain": gain((L, GMLP_HEADS, HEAD_DIM)),
        "w_spatial": nrm((L, GMLP_HEADS, CHUNK, CHUNK), CHUNK ** -0.5),
        "b_spatial": gain((L, GMLP_HEADS, CHUNK)),
        "w_pool": nrm((L, POOL_GROUPS, POOL_GROUP_WIDTH, POOL_GROUP_WIDTH), POOL_GROUP_WIDTH ** -0.5),
        "s_pool": gain((L, POOL_WIDTH)),
        "w_dw": nrm((L, CONV_K, CONV_WIDTH), CONV_K ** -0.5),
        "b_dw": nrm((L, CONV_WIDTH), 0.02),
        "conv_ln_g": gain((L, CONV_WIDTH)),
        "conv_ln_b": nrm((L, CONV_WIDTH), 0.02),
        "norm_xattn_pre": gain((L, D_MODEL)),
        "norm_mem": gain((L, D_MODEL)),
        "norm_xattn_post": gain((L, D_MODEL)),
        "w_q": nrm((L, D_MODEL, D_MODEL), D_MODEL ** -0.5),
        "w_k": nrm((L, D_MODEL, D_MODEL), D_MODEL ** -0.5),
        "w_v": nrm((L, D_MODEL, D_MODEL), D_MODEL ** -0.5),
        "w_o": nrm((L, D_MODEL, D_MODEL), D_MODEL ** -0.5),
        "norm_ffn_pre": gain((L, D_MODEL)),
        "norm_ffn_post": gain((L, D_MODEL)),
        "w_up": nrm((L, D_MODEL, D_FF), D_MODEL ** -0.5),
        "w_down": nrm((L, D_FF, D_MODEL), D_FF ** -0.5),
    }


def reference(x, mem, norm_mix_pre, norm_mix_post, w_in, w_out, gmlp_v_gain, w_spatial,
              b_spatial, w_pool, s_pool, w_dw, b_dw, conv_ln_g, conv_ln_b, norm_xattn_pre,
              norm_mem, norm_xattn_post, w_q, w_k, w_v, w_o, norm_ffn_pre, norm_ffn_post,
              w_up, w_down):
    for l in range(DEPTH):
        h = rms_norm(x, norm_mix_pre[l])
        h = hybrid_mixer(h, w_in[l], w_out[l], gmlp_v_gain[l], w_spatial[l], b_spatial[l],
                         w_pool[l], s_pool[l], w_dw[l], b_dw[l], conv_ln_g[l], conv_ln_b[l])
        x = x + rms_norm(h, norm_mix_post[l])
        h = rms_norm(x, norm_xattn_pre[l])
        m = rms_norm(mem, norm_mem[l])
        h = cross_attention(h, m, w_q[l], w_k[l], w_v[l], w_o[l])
        x = x + rms_norm(h, norm_xattn_post[l])
        h = rms_norm(x, norm_ffn_pre[l])
        h = jnp.square(jax.nn.relu(h @ w_up[l])) @ w_down[l]
        x = x + rms_norm(h, norm_ffn_post[l])
    return x
```

```cpp
#include <hip/hip_runtime.h>
#include <cstdio>
#include <cstdint>

#define LAS __attribute__((address_space(3)))
#define GAS __attribute__((address_space(1)))
typedef unsigned short bf16_t;
typedef short bf16x8 __attribute__((ext_vector_type(8)));
typedef float f32x4 __attribute__((ext_vector_type(4)));
typedef float f32x2 __attribute__((ext_vector_type(2)));
typedef unsigned u32x4 __attribute__((ext_vector_type(4)));
typedef unsigned u32x2 __attribute__((ext_vector_type(2)));

constexpr int D = 2048, NB = 4, SEQ = 2048, NL = 2, MEM = 256, GW = 1024, PW = 512, CW = 512, NIN = 3584, GH = 8, HD = 128, CH = 128, PG = 4, CK = 31, XH = 4, XD = 512, FF = 8192;
constexpr int M = NB * SEQ, MM = NB * MEM;
constexpr float RMS_EPS = 1e-6f, LN_EPS = 1e-5f;

constexpr size_t MiB = 1u << 20;
constexpr size_t WS_CTL = 0, CTL_ZERO_BYTES = 32 * 1024;
constexpr size_t WS_WPT = 1 * MiB, WS_WSM = 1 * MiB + 256 * 1024;
constexpr size_t WS_W = 2 * MiB, W_LAYER = 118 * MiB;
constexpr size_t WO_IN = 0, WO_OUT = 14 * MiB, WO_Q = 22 * MiB, WO_KV = 30 * MiB, WO_O = 46 * MiB, WO_UP = 54 * MiB, WO_DN = 86 * MiB;
constexpr size_t WS_MN = 238 * MiB;
constexpr size_t WS_KB = 246 * MiB, WS_VB = 250 * MiB, WS_VT = WS_VB;
constexpr size_t WS_XN = 254 * MiB;
constexpr size_t WS_HB = 286 * MiB;
constexpr size_t WS_BIG = 350 * MiB;
constexpr size_t BO_Z = 0, BO_Y = 56 * MiB, BO_Q = 0, BO_P = 32 * MiB, BO_O = 64 * MiB, BO_UP = 0;
constexpr size_t BO_GT = 0, BO_UT = 16 * MiB;
constexpr size_t WS_XH = 478 * MiB;
constexpr size_t WS_GR = 510 * MiB;
constexpr size_t WS_END = 511 * MiB;
constexpr int CW_BAR = 4096;

constexpr int RING_BYTES = 131072, LDSCTL_OFF = RING_BYTES, MISC_OFF = LDSCTL_OFF + 320, LDS_BYTES = 147456;
constexpr int NWAVES = 8;

#define LDS_WAIT() asm volatile("s_waitcnt lgkmcnt(0)" ::: "memory")
#define VM_WAIT() asm volatile("s_waitcnt vmcnt(0)" ::: "memory")
#define RLX_AGENT __ATOMIC_RELAXED, __HIP_MEMORY_SCOPE_AGENT

__device__ __forceinline__ unsigned cvt_pk_bf16(float lo, float hi) { unsigned r; asm volatile("v_cvt_pk_bf16_f32 %0, %1, %2" : "=v"(r) : "v"(lo), "v"(hi)); return r; }
__device__ __forceinline__ float bf_lo(unsigned w) { return __builtin_bit_cast(float, w << 16); }
__device__ __forceinline__ float bf_hi(unsigned w) { return __builtin_bit_cast(float, w & 0xffff0000u); }
typedef _Float16 f16x2 __attribute__((ext_vector_type(2)));
__device__ __forceinline__ unsigned pk_f16(float a, float b) { f16x2 v; v[0] = (_Float16)a; v[1] = (_Float16)b; return __builtin_bit_cast(unsigned, v); }
__device__ __forceinline__ f32x2 unpk_f16(unsigned w) { const f16x2 v = __builtin_bit_cast(f16x2, w); const _Float16 a = v[0], b = v[1]; return (f32x2){(float)a, (float)b}; }
__device__ __forceinline__ float fast_sigmoid(float x) { return __builtin_amdgcn_rcpf(1.f + __builtin_amdgcn_exp2f(-1.44269504089f * x)); }
__device__ __forceinline__ float gelu_tanh(float x) { const float u = 0.7978845608028654f * (x + 0.044715f * x * x * x); return x * fast_sigmoid(2.f * u); }
__device__ __forceinline__ int opaque_s(int v) { asm volatile("" : "+s"(v)); return v; }
__device__ __forceinline__ int fresh_tid() { int t = threadIdx.x; asm volatile("" : "+v"(t)); return t; }
template <int CTRL> __device__ __forceinline__ float dppf(float v) { return __builtin_bit_cast(float, __builtin_amdgcn_update_dpp(0, __builtin_bit_cast(int, v), CTRL, 0xf, 0xf, true)); }
__device__ __forceinline__ float lx1(float v) { return dppf<0xB1>(v); }
__device__ __forceinline__ float lx2(float v) { return dppf<0x4E>(v); }
__device__ __forceinline__ float lx16(float v) { return __builtin_bit_cast(float, __builtin_amdgcn_ds_swizzle(__builtin_bit_cast(int, v), 0x401F)); }
__device__ __forceinline__ void halves32(float v, float& lo, float& hi) {
    const unsigned u = __builtin_bit_cast(unsigned, v); auto r = __builtin_amdgcn_permlane32_swap(u, u, false, false);
    const unsigned r0 = r[0], r1 = r[1];
    lo = __builtin_bit_cast(float, r0); hi = __builtin_bit_cast(float, r1); }
__device__ __forceinline__ float sum_x32(float v) { float a, b; halves32(v, a, b); return a + b; }
__device__ __forceinline__ float max_x32(float v) { float a, b; halves32(v, a, b); return fmaxf(a, b); }
__device__ __forceinline__ float wave_sum(float v) {
    v += lx1(v); v += lx2(v); v += dppf<0x141>(v)  ; v += dppf<0x140>(v)  ; v += lx16(v); return sum_x32(v);
}

#define XB_TMO      128
#define XB_XCNT(j)  (256  + 64 * (j))
#define XB_XSUB(j)  (1280 + 64 * (j))
#define XB_XGEN(j)  (2304 + 64 * (j))
#define XB_TOP      3328
#define XB_TOPGEN   3392
#define XCD_BAR_WORDS 3456
#define XB_SPIN_CAP (1u << 18)
__device__ __forceinline__ unsigned xb_ld(unsigned* p)              { return __hip_atomic_load(p, __ATOMIC_RELAXED, __HIP_MEMORY_SCOPE_AGENT); }
__device__ __forceinline__ unsigned xb_add(unsigned* p, unsigned v) { return __hip_atomic_fetch_add(p, v, __ATOMIC_RELAXED, __HIP_MEMORY_SCOPE_AGENT); }
__device__ __forceinline__ unsigned xb_xcc_id() { return (unsigned)__builtin_amdgcn_s_getreg((3 << 11) | 20) & 0xFu; }
#define XB_SPIN(cond, bar) do { unsigned _sp = 0; while (cond) { __builtin_amdgcn_s_sleep(1); \
    if ((++_sp & 255u) == 0u) { if (xb_ld(&(bar)[XB_TMO])) break; if (_sp > XB_SPIN_CAP) { atomicAdd(&(bar)[XB_TMO], 1u); break; } } } } while (0)
struct XcdBarrier { unsigned* bar; unsigned x; volatile LAS unsigned* st; };
__device__ __forceinline__ XcdBarrier xcd_barrier_post(unsigned* bar, volatile LAS unsigned* st) {
    XcdBarrier b; b.bar = bar; b.x = xb_xcc_id(); b.st = st;
    if (threadIdx.x == 0) (void)xb_add(&bar[XB_XCNT(b.x)], 1u);
    return b;
}
__device__ __forceinline__ void xcd_barrier_complete(unsigned* bar, unsigned x, unsigned& nloc, unsigned& nx) {
    const unsigned G = gridDim.x * gridDim.y * gridDim.z;
    unsigned sum, cnt, mine, sp = 0u;
    for (;;) {
        sum = 0u; cnt = 0u; mine = 0u;
#pragma unroll
        for (unsigned j = 0; j < 16; ++j) { const unsigned c = xb_ld(&bar[XB_XCNT(j)]); sum += c; cnt += (c > 0u) ? 1u : 0u; mine = (j == x) ? c : mine; }
        if (sum == G) break;
        __builtin_amdgcn_s_sleep(1);
        if ((++sp & 255u) == 0u) { if (xb_ld(&bar[XB_TMO])) break; if (sp > XB_SPIN_CAP) { atomicAdd(&bar[XB_TMO], 1u); break; } }
    }
    nloc = mine > 0u ? mine : 1u; nx = cnt > 0u ? cnt : 1u;
}
__device__ __forceinline__ void xcd_barrier(const XcdBarrier& b) {
    asm volatile("s_waitcnt vmcnt(0)" ::: "memory");
    __syncthreads();
    if (threadIdx.x == 0) {
        unsigned* bar = b.bar; asm volatile("" : "+s"(bar));
        __builtin_amdgcn_s_waitcnt(0);
        unsigned nloc = b.st[0], nx = b.st[1]; unsigned bx = b.x; asm volatile("" : "+s"(bx));
        if (nloc == 0u) { xcd_barrier_complete(bar, bx, nloc, nx); b.st[0] = nloc; b.st[1] = nx; }
        const unsigned old = xb_add(&bar[XB_XSUB(bx)], 1u);
        const unsigned gen = old / nloc;
        if (old + 1u == (gen + 1u) * nloc) {
            __builtin_amdgcn_fence(__ATOMIC_RELEASE, "agent");
            asm volatile("s_waitcnt vmcnt(0)" ::: "memory");
            const unsigned og = xb_add(&bar[XB_TOP], 1u);
            const unsigned tg = og / nx;
            if (og + 1u == (tg + 1u) * nx) xb_add(&bar[XB_TOPGEN], 1u);
            else XB_SPIN(xb_ld(&bar[XB_TOPGEN]) == tg, bar);
            __builtin_amdgcn_fence(__ATOMIC_ACQUIRE, "agent");
            xb_add(&bar[XB_XGEN(bx)], 1u);
            asm volatile("s_waitcnt vmcnt(0)" ::: "memory");
        } else {
            XB_SPIN(xb_ld(&bar[XB_XGEN(bx)]) == gen, bar);
            __builtin_amdgcn_fence(__ATOMIC_ACQUIRE, "agent");
            asm volatile("s_waitcnt vmcnt(0)" ::: "memory");
        }
    }
    __syncthreads();
}

namespace pg8 {
constexpr int BM = 256, BK = 64, HALF = 128, HTB = HALF * BK * 2, STAGE_BYTES = 8 * HTB, NXCD = 8, WGM = 8;
__host__ __device__ __forceinline__ int lds_byte(int r, int c) { const int st = (r >> 4) * 2 + (c >> 5), rr = r & 15, cc = c & 31, ob = rr * 64 + cc * 2; return st * 1024 + (ob ^ (((ob >> 9) & 1) << 5)); }
__host__ __device__ __forceinline__ void stage_rc(int b, int& R, int& C) { const int st = b / 1024, sb = b % 1024, swz = sb ^ (((sb >> 9) & 1) << 5); R = (st >> 1) * 16 + swz / 64; C = (st & 1) * 32 + (swz % 64) / 2; }
__host__ __device__ __forceinline__ int perm32(int rho) { const int n = rho >> 4, i = rho & 15; return 8 * (i >> 2) + 4 * n + (i & 3); }

struct Unit { const char* A; const char* B; void* O; int ldo, pm, pn, flag, nt; };

__device__ __forceinline__ void tile_order(int L, int nM, int nN, int& pm, int& pn) {
    const int nwg = nM * nN; int wgid = L; { const int q = nwg / NXCD, r = nwg % NXCD, xcd = wgid % NXCD, off = wgid / NXCD; wgid = (xcd < r ? xcd * (q + 1) : r * (q + 1) + (xcd - r) * q) + off; }
    const int nig = WGM * nN, gid = wgid / nig, fm = gid * WGM, gsz = (nM - fm) < WGM ? (nM - fm) : WGM;
    pm = fm + ((wgid % nig) % gsz); pn = (wgid % nig) / gsz;
}

struct EpiF32 {
    static constexpr bool PERM = false, AFTER_DRAIN = false;
    __device__ __forceinline__ void operator()(const f32x4 (&acc)[2][2][4][2], const Unit& u, int wr, int wc, int fr, int fq) const {
        { const int t_ = fresh_tid(); fr = t_ & 15; fq = (t_ >> 4) & 3; }
        const int row0 = u.pm * BM + wr * 64 + fr, col0 = u.pn * BM + wc * 32 + 4 * fq; float* C = (float*)u.O;
#pragma unroll
        for (int ai = 0; ai < 2; ++ai)
#pragma unroll
            for (int m = 0; m < 4; ++m) { float* rowp = C + (size_t)(row0 + ai * HALF + m * 16) * u.ldo + col0;
#pragma unroll
                for (int bj = 0; bj < 2; ++bj)
#pragma unroll
                    for (int n = 0; n < 2; ++n) *(f32x4*)(rowp + bj * HALF + n * 16) = acc[ai][bj][m][n]; }
    }
};
template <int ACT> struct EpiBf16 {
    static constexpr bool PERM = true, AFTER_DRAIN = false;
    __device__ __forceinline__ void operator()(const f32x4 (&acc)[2][2][4][2], const Unit& u, int wr, int wc, int fr, int fq) const {
        { const int t_ = fresh_tid(); fr = t_ & 15; fq = (t_ >> 4) & 3; }
        const int row0 = u.pm * BM + wr * 64 + fr, col0 = u.pn * BM + wc * 32 + 8 * fq; bf16_t* base = (bf16_t*)u.O;
        const bool act1 = (ACT == 1) && (u.flag != 0);
#pragma unroll
        for (int ai = 0; ai < 2; ++ai)
#pragma unroll
            for (int m = 0; m < 4; ++m) { bf16_t* rowp = base + (size_t)(row0 + ai * HALF + m * 16) * u.ldo + col0;
#pragma unroll
                for (int bj = 0; bj < 2; ++bj) { f32x4 v0 = acc[ai][bj][m][0], v1 = acc[ai][bj][m][1];
                    if (ACT == 1) { if (act1) {
#pragma unroll
                        for (int e = 0; e < 4; ++e) { v0[e] = gelu_tanh(v0[e]); v1[e] = gelu_tanh(v1[e]); } } }
                    if (ACT == 2) {
#pragma unroll
                        for (int e = 0; e < 4; ++e) { const float a = fmaxf(v0[e], 0.f), b = fmaxf(v1[e], 0.f); v0[e] = a * a; v1[e] = b * b; } }
                    u32x4 w; w.x = cvt_pk_bf16(v0[0], v0[1]); w.y = cvt_pk_bf16(v0[2], v0[3]); w.z = cvt_pk_bf16(v1[0], v1[1]); w.w = cvt_pk_bf16(v1[2], v1[3]);
                    *(u32x4*)(rowp + bj * HALF) = w; } }
    }
};
struct EpiSoftmax {
    static constexpr bool PERM = true, AFTER_DRAIN = true, INLOOP = false;
    float scale_log2e;
    __device__ __forceinline__ void fused(f32x4 (&acc)[2][2][4][2], const Unit& u, int wr, int wc, int fr, int fq, LAS unsigned char* lds, int wid, int lane) const {
        LAS f32x2* P = (LAS f32x2*)lds;
#pragma unroll
        for (int ai = 0; ai < 2; ++ai)
#pragma unroll
            for (int m = 0; m < 4; ++m) {
                float mx = -3.0e38f;
#pragma unroll
                for (int bj = 0; bj < 2; ++bj)
#pragma unroll
                    for (int n = 0; n < 2; ++n) { const f32x4 x = acc[ai][bj][m][n]; mx = fmaxf(mx, fmaxf(fmaxf(x[0], x[1]), fmaxf(x[2], x[3]))); }
                mx = fmaxf(mx, lx16(mx)); mx = max_x32(mx);
                float s = 0.f;
#pragma unroll
                for (int bj = 0; bj < 2; ++bj)
#pragma unroll
                    for (int n = 0; n < 2; ++n) { f32x4 x = acc[ai][bj][m][n];
#pragma unroll
                        for (int e = 0; e < 4; ++e) { x[e] = __builtin_amdgcn_exp2f((x[e] - mx) * scale_log2e); s += x[e]; }
                        acc[ai][bj][m][n] = x; }
                s += lx16(s); s = sum_x32(s);
                if (fq == 0) P[(ai * HALF + wr * 64 + m * 16 + fr) * 4 + wc] = (f32x2){mx, s};
            }
        asm volatile("s_waitcnt lgkmcnt(0)" ::: "memory"); __builtin_amdgcn_s_barrier(); asm volatile("" ::: "memory");
        const int row0 = u.pm * BM + wr * 64 + fr, col0 = u.pn * BM + wc * 32 + 8 * fq; bf16_t* base = (bf16_t*)u.O;
#pragma unroll
        for (int ai = 0; ai < 2; ++ai)
#pragma unroll
            for (int m = 0; m < 4; ++m) {
                const int r = ai * HALF + wr * 64 + m * 16 + fr;
                const f32x2 a = P[r * 4 + 0], b = P[r * 4 + 1], c = P[r * 4 + 2], d = P[r * 4 + 3];
                const float mt = fmaxf(fmaxf(a.x, b.x), fmaxf(c.x, d.x));
                const float ea = __builtin_amdgcn_exp2f((a.x - mt) * scale_log2e), eb = __builtin_amdgcn_exp2f((b.x - mt) * scale_log2e), ec = __builtin_amdgcn_exp2f((c.x - mt) * scale_log2e), ed = __builtin_amdgcn_exp2f((d.x - mt) * scale_log2e);
                const float tot = a.y * ea + b.y * eb + c.y * ec + d.y * ed;
                const float mine = (wc == 0 ? ea : wc == 1 ? eb : wc == 2 ? ec : ed) / tot;
                bf16_t* rowp = base + (size_t)(row0 + ai * HALF + m * 16) * u.ldo + col0;
#pragma unroll
                for (int bj = 0; bj < 2; ++bj) { const f32x4 v0 = acc[ai][bj][m][0] * mine, v1 = acc[ai][bj][m][1] * mine;
                    u32x4 w; w.x = cvt_pk_bf16(v0[0], v0[1]); w.y = cvt_pk_bf16(v0[2], v0[3]); w.z = cvt_pk_bf16(v1[0], v1[1]); w.w = cvt_pk_bf16(v1[2], v1[3]);
                    *(u32x4*)(rowp + bj * HALF) = w; }
            }
    }
};

struct NormX { const float* g_post; const float* g_pre; float* out; unsigned char* ws; unsigned epoch; };
template <bool LAST> struct EpiNorm {
    static constexpr bool PERM = true, AFTER_DRAIN = true, INLOOP = true;
    NormX nx;
    __device__ __forceinline__ void operator()(const f32x4 (&acc)[2][2][4][2], const Unit& u, int wr, int wc, int fr, int fq) const { EpiBf16<0>{}(acc, u, wr, wc, fr, fq); }
    __device__ __forceinline__ void row_exchange(float (&s)[2][4], LAS float* T, LAS float* R, unsigned long long* GRb, unsigned epoch, int rb, int pn, int tid, int wr, int wc, int fr, int fq) const {
#pragma unroll
        for (int ai = 0; ai < 2; ++ai)
#pragma unroll
            for (int m = 0; m < 4; ++m) { float v = s[ai][m]; v += lx16(v); v = sum_x32(v); if (fq == 0) T[(ai * HALF + wr * 64 + m * 16 + fr) * 4 + wc] = v; }
        asm volatile("s_waitcnt lgkmcnt(0)" ::: "memory"); __syncthreads();
        if (tid < 256) {
            const f32x4 t4 = *(const LAS f32x4*)(T + tid * 4); const float tot = (t4.x + t4.y) + (t4.z + t4.w);
            GAS unsigned long long* g = (GAS unsigned long long*)(GRb + (size_t)(rb + tid) * 8);
            __hip_atomic_store(g + pn, ((unsigned long long)epoch << 32) | (unsigned long long)__builtin_bit_cast(unsigned, tot), __ATOMIC_RELAXED, __HIP_MEMORY_SCOPE_AGENT);
            float sum = 0.f;
            for (unsigned sp = 0; sp < (1u << 20); ++sp) { bool ok = true; sum = 0.f;
#pragma unroll
                for (int k = 0; k < 8; ++k) { const unsigned long long x = __hip_atomic_load(g + k, __ATOMIC_RELAXED, __HIP_MEMORY_SCOPE_AGENT); ok &= (unsigned)(x >> 32) == epoch; sum += __builtin_bit_cast(float, (unsigned)x); }
                if (__all(ok)) break;
                __builtin_amdgcn_s_sleep(1); }
            R[tid] = 1.f / sqrtf(sum * (1.f / 2048.f) + 1e-6f);
        }
        asm volatile("s_waitcnt lgkmcnt(0)" ::: "memory"); __syncthreads();
#pragma unroll
        for (int ai = 0; ai < 2; ++ai)
#pragma unroll
            for (int m = 0; m < 4; ++m) s[ai][m] = R[ai * HALF + wr * 64 + m * 16 + fr];
    }
    __device__ __forceinline__ void xprime(f32x4 (&acc)[2][2][4][2], float (&s)[2][4], u32x4 (&xw)[4][2], const f32x4 (&gp)[2][2], unsigned short* XR, unsigned o2) const {
#pragma unroll
        for (int ai = 0; ai < 2; ++ai)
#pragma unroll
            for (int m = 0; m < 4; ++m) { const float rs = s[ai][m]; float q = 0.f; const unsigned ro = o2 + (unsigned)((ai * HALF + m * 16) * 2048);
#pragma unroll
                for (int bj = 0; bj < 2; ++bj) { const u32x4 w = xw[m][bj]; if (ai == 0) xw[m][bj] = __builtin_nontemporal_load((const GAS u32x4*)(XR + (ro + (unsigned)(HALF * 2048 + bj * HALF)))); const f32x2 x0 = unpk_f16(w.x), x1 = unpk_f16(w.y), x2 = unpk_f16(w.z), x3 = unpk_f16(w.w);
                    f32x4 a = (f32x4){x0.x, x0.y, x1.x, x1.y}, b = (f32x4){x2.x, x2.y, x3.x, x3.y};
                    a = a + acc[ai][bj][m][0] * rs * gp[bj][0]; b = b + acc[ai][bj][m][1] * rs * gp[bj][1];
                    acc[ai][bj][m][0] = a; acc[ai][bj][m][1] = b;
                    q += ((a[0] * a[0] + a[1] * a[1]) + (a[2] * a[2] + a[3] * a[3])) + ((b[0] * b[0] + b[1] * b[1]) + (b[2] * b[2] + b[3] * b[3]));
                    if constexpr (LAST) { GAS f32x4* o = (GAS f32x4*)(nx.out + (ro + (unsigned)(bj * HALF))); o[0] = a; o[1] = b; }
                    else { u32x4 o; o.x = pk_f16(a[0], a[1]); o.y = pk_f16(a[2], a[3]); o.z = pk_f16(b[0], b[1]); o.w = pk_f16(b[2], b[3]); *(GAS u32x4*)(XR + (ro + (unsigned)(bj * HALF))) = o; } }
                s[ai][m] = q; }
    }
    __device__ __forceinline__ void fused(f32x4 (&acc)[2][2][4][2], const Unit& u, int, int, int, int, LAS unsigned char* lds, int, int) const {
        const int tid = fresh_tid(), lane = tid & 63, wid = __builtin_amdgcn_readfirstlane(tid >> 6), wr = wid >> 2, wc = wid & 3, fr = lane & 15, fq = lane >> 4;
        LAS float* T = (LAS float*)lds; LAS float* R = T + 1024;
        const int rb = u.pm * BM, lr0 = wr * 64 + fr, cb = u.pn * BM + wc * 32 + 8 * fq;
        unsigned short* XR = (unsigned short*)(nx.ws + WS_XH); unsigned long long* GR = (unsigned long long*)(nx.ws + WS_GR);
        u32x4 xw[4][2];
#pragma unroll
        for (int m = 0; m < 4; ++m)
#pragma unroll
            for (int bj = 0; bj < 2; ++bj) xw[m][bj] = __builtin_nontemporal_load((const GAS u32x4*)(XR + (unsigned)((rb + lr0 + m * 16) * 2048 + cb + bj * HALF)));
        f32x4 gp[2][2];
#pragma unroll
        for (int bj = 0; bj < 2; ++bj)
#pragma unroll
            for (int n = 0; n < 2; ++n) gp[bj][n] = *(const GAS f32x4*)(nx.g_post + cb + bj * HALF + 4 * n);
        float s[2][4];
#pragma unroll
        for (int ai = 0; ai < 2; ++ai)
#pragma unroll
            for (int m = 0; m < 4; ++m) { float q = 0.f;
#pragma unroll
                for (int bj = 0; bj < 2; ++bj)
#pragma unroll
                    for (int n = 0; n < 2; ++n) { const f32x4 h = acc[ai][bj][m][n]; q += (h[0] * h[0] + h[1] * h[1]) + (h[2] * h[2] + h[3] * h[3]); }
                s[ai][m] = q; }
        row_exchange(s, T, R, GR, nx.epoch, rb, u.pn, tid, wr, wc, fr, fq);
        const int t2 = fresh_tid(), w2 = __builtin_amdgcn_readfirstlane(t2 >> 6); const unsigned o2 = (unsigned)((rb + (w2 >> 2) * 64 + (t2 & 15)) * 2048 + u.pn * BM + (w2 & 3) * 32 + 8 * ((t2 & 63) >> 4));
        xprime(acc, s, xw, gp, XR, o2);
        if constexpr (LAST) return;
        f32x4 gq[2][2];
#pragma unroll
        for (int bj = 0; bj < 2; ++bj)
#pragma unroll
            for (int n = 0; n < 2; ++n) gq[bj][n] = *(const GAS f32x4*)(nx.g_pre + (o2 & 2047u) + bj * HALF + 4 * n);
        row_exchange(s, T, R, GR + (size_t)8192 * 8, nx.epoch + 1u, rb, u.pn, tid, wr, wc, fr, fq);
        bf16_t* XNp = (bf16_t*)(nx.ws + WS_XN);
        const int t3 = fresh_tid(), w3 = __builtin_amdgcn_readfirstlane(t3 >> 6); const unsigned o3 = (unsigned)((rb + (w3 >> 2) * 64 + (t3 & 15)) * 2048 + u.pn * BM + (w3 & 3) * 32 + 8 * ((t3 & 63) >> 4));
#pragma unroll
        for (int ai = 0; ai < 2; ++ai)
#pragma unroll
            for (int m = 0; m < 4; ++m) { const float rs = s[ai][m]; const unsigned ro = o3 + (unsigned)((ai * HALF + m * 16) * 2048);
#pragma unroll
                for (int bj = 0; bj < 2; ++bj) { const f32x4 a = acc[ai][bj][m][0] * rs * gq[bj][0], b = acc[ai][bj][m][1] * rs * gq[bj][1];
                    u32x4 o; o.x = cvt_pk_bf16(a[0], a[1]); o.y = cvt_pk_bf16(a[2], a[3]); o.z = cvt_pk_bf16(b[0], b[1]); o.w = cvt_pk_bf16(b[2], b[3]);
                    *(GAS u32x4*)(XNp + (ro + (unsigned)(bj * HALF))) = o; } }
    }
};

template <class Epi, class Sched>
__device__ __forceinline__ void gemm_phase(LAS unsigned char* lds, const int lda, const int ldb, const Sched& S, const Epi& E) {
    const int tid = fresh_tid(), wid = __builtin_amdgcn_readfirstlane(tid >> 6), lane = tid & 63, wr = wid >> 2, wc = wid & 3, fr = lane & 15, fq = lane >> 4;
    unsigned voffA[2], voffB[2];
#pragma unroll
    for (int i = 0; i < 2; ++i) { int R, C; stage_rc(tid * 16 + i * 8192, R, C); const int Rb = Epi::PERM ? ((R & ~31) + perm32(R & 31)) : R;
        voffA[i] = (unsigned)(R * lda + C) * 2u; voffB[i] = (unsigned)(Rb * ldb + C) * 2u; }
    const size_t kstep = (size_t)(BK * 2);
    const size_t hstepA = (size_t)HALF * lda * 2, hstepB = (size_t)HALF * ldb * 2;
    const unsigned ldsw = (unsigned)wid * 1024u;
    const int aoff = lds_byte(wr * 64 + fr, fq * 8), boff = lds_byte(wc * 32 + fr, fq * 8);
#define PG8_SA(b, h) (((b) * 2 + (h)) * HTB)
#define PG8_SB(b, h) ((4 + (b) * 2 + (h)) * HTB)
#define PG8_STAGE(bufoff, gbase, voff) do { _Pragma("unroll") for (int _i = 0; _i < 2; ++_i) \
        __builtin_amdgcn_global_load_lds((const unsigned*)((const char*)(gbase) + (voff)[_i]), (LAS unsigned*)(lds + (bufoff) + ldsw + _i * 8192), 16, 0, 0); } while (0)
#define PG8_LDA(dst, b, h) do { _Pragma("unroll") for (int m = 0; m < 4; ++m) _Pragma("unroll") for (int k = 0; k < 2; ++k) dst[m][k] = *(const LAS bf16x8*)(lds + PG8_SA(b, h) + aoff + m * 2048 + k * 1024); } while (0)
#define PG8_LDB(dst, b, h) do { _Pragma("unroll") for (int n = 0; n < 2; ++n) _Pragma("unroll") for (int k = 0; k < 2; ++k) dst[n][k] = *(const LAS bf16x8*)(lds + PG8_SB(b, h) + boff + n * 2048 + k * 1024); } while (0)
#define PG8_MMA(ai, bj, At, Bt) do { __builtin_amdgcn_s_setprio(1); _Pragma("unroll") for (int m = 0; m < 4; ++m) _Pragma("unroll") for (int n = 0; n < 2; ++n) _Pragma("unroll") for (int k = 0; k < 2; ++k) \
        acc[ai][bj][m][n] = __builtin_amdgcn_mfma_f32_16x16x32_bf16(Bt[n][k], At[m][k], acc[ai][bj][m][n], 0, 0, 0); __builtin_amdgcn_s_setprio(0); } while (0)
#define PG8_WAIT_V(n) asm volatile("s_waitcnt vmcnt(" #n ")" ::: "memory")
#define PG8_WAIT_L(n) asm volatile("s_waitcnt lgkmcnt(" #n ")" ::: "memory")
#define PG8_BAR __builtin_amdgcn_s_barrier()
#define PG8_SCHED __builtin_amdgcn_sched_barrier(0)
    Unit cur, nxt; int ui = 0;
    if (!S.next(0, cur)) return;
    f32x4 acc[2][2][4][2];
#pragma unroll
    for (int a = 0; a < 2; ++a)
#pragma unroll
        for (int b = 0; b < 2; ++b)
#pragma unroll
            for (int m = 0; m < 4; ++m)
#pragma unroll
                for (int n = 0; n < 2; ++n) acc[a][b][m][n] = (f32x4){0.f, 0.f, 0.f, 0.f};
    bf16x8 At[4][2], B0[2][2], B1[2][2];
    const char* cA = cur.A; const char* cB = cur.B;
    PG8_STAGE(PG8_SB(0, 0), cB, voffB); PG8_STAGE(PG8_SB(0, 1), cB + hstepB, voffB); PG8_STAGE(PG8_SA(0, 0), cA, voffA); PG8_STAGE(PG8_SA(0, 1), cA + hstepA, voffA);
    if (wr == 1) PG8_BAR;
    PG8_WAIT_V(2); PG8_BAR;
    PG8_STAGE(PG8_SB(1, 0), cB + kstep, voffB); PG8_STAGE(PG8_SA(1, 0), cA + kstep, voffA); PG8_STAGE(PG8_SB(1, 1), cB + hstepB + kstep, voffB);
    PG8_WAIT_V(6); PG8_BAR;
    for (;;) {
        const bool has_next = S.next(ui + 1, nxt);
        const char* nA = has_next ? nxt.A : cA; const char* nB = has_next ? nxt.B : cB;
        const int nt = cur.nt;
        for (int t = 0; t < nt; t += 2) {
            const bool last = (t == nt - 2);
            const char* a1 = cA + (size_t)(t + 1) * kstep;
            const char* a2 = last ? nA : cA + (size_t)(t + 2) * kstep; const char* b2 = last ? nB : cB + (size_t)(t + 2) * kstep;
            const char* a3 = a2 + kstep; const char* b3 = b2 + kstep;
            PG8_LDB(B0, 0, 0); PG8_LDB(B1, 0, 1); PG8_SCHED; PG8_LDA(At, 0, 0); PG8_STAGE(PG8_SA(1, 1), a1 + hstepA, voffA);
            PG8_WAIT_V(8); PG8_WAIT_L(0); PG8_BAR; PG8_MMA(0, 0, At, B0); PG8_MMA(0, 1, At, B1); PG8_BAR; PG8_SCHED;
            PG8_LDA(At, 0, 1); PG8_STAGE(PG8_SB(0, 0), b2, voffB); PG8_STAGE(PG8_SB(0, 1), b2 + hstepB, voffB); PG8_STAGE(PG8_SA(0, 0), a2, voffA);
            PG8_WAIT_V(8); PG8_WAIT_L(0); PG8_BAR; PG8_MMA(1, 0, At, B0); PG8_MMA(1, 1, At, B1); PG8_BAR; PG8_SCHED;
            PG8_LDB(B0, 1, 0); PG8_LDB(B1, 1, 1); PG8_SCHED; PG8_LDA(At, 1, 0); PG8_STAGE(PG8_SA(0, 1), a2 + hstepA, voffA);
            PG8_WAIT_V(8); PG8_WAIT_L(0); PG8_BAR; PG8_MMA(0, 0, At, B0); PG8_MMA(0, 1, At, B1); PG8_BAR; PG8_SCHED;
            PG8_LDA(At, 1, 1); PG8_STAGE(PG8_SB(1, 0), b3, voffB); PG8_STAGE(PG8_SB(1, 1), b3 + hstepB, voffB); PG8_STAGE(PG8_SA(1, 0), a3, voffA);
            PG8_WAIT_V(8); PG8_WAIT_L(0); PG8_BAR; PG8_MMA(1, 0, At, B0); PG8_MMA(1, 1, At, B1); PG8_BAR; PG8_SCHED;
        }
        if (wr == 0) PG8_BAR;
        if constexpr (!Epi::AFTER_DRAIN) { E(acc, cur, wr, wc, fr, fq); }
        else if constexpr (Epi::INLOOP) { if (has_next) E(acc, cur, wr, wc, fr, fq); }
        if (!has_next) break;
#pragma unroll
        for (int a = 0; a < 2; ++a)
#pragma unroll
            for (int b = 0; b < 2; ++b)
#pragma unroll
                for (int m = 0; m < 4; ++m)
#pragma unroll
                    for (int n = 0; n < 2; ++n) acc[a][b][m][n] = (f32x4){0.f, 0.f, 0.f, 0.f};
        cur = nxt; cA = nA; cB = nB; ++ui;
        if (wr == 1) PG8_BAR;
    }
    PG8_WAIT_V(0);
    PG8_BAR;
    if constexpr (Epi::AFTER_DRAIN) { E.fused(acc, cur, wr, wc, fr, fq, lds, wid, lane); }
#undef PG8_SA
#undef PG8_SB
#undef PG8_STAGE
#undef PG8_LDA
#undef PG8_LDB
#undef PG8_MMA
#undef PG8_WAIT_V
#undef PG8_WAIT_L
#undef PG8_BAR
#undef PG8_SCHED
}
}

template <int LDA, int LDB, int LDO, int NM, int NN, int KD> struct SchedPlain {
    const char* A; const char* B; void* O; int G, c;
    __device__ __forceinline__ bool next(int i, pg8::Unit& u) const {
        const int L = i * G + c; if (L >= NM * NN) return false;
        int pm, pn; pg8::tile_order(L, NM, NN, pm, pn);
        u.A = A + (size_t)pm * 256 * LDA * 2; u.B = B + (size_t)pn * 256 * LDB * 2; u.O = O; u.ldo = LDO; u.pm = pm; u.pn = pn; u.flag = 0; u.nt = KD / 64; return true;
    }
};
struct SchedIn {
    const char* ws; const char* wl; const char* mn; int G, c;
    __device__ __forceinline__ bool next(int i, pg8::Unit& u) const {
        const int L = i * G + c; if (L >= 512) return false;
        int pm, pn; pg8::tile_order(L < 448 ? L : 0, 32, 14, pm, pn);
        const int Lk = L - 448, Lv = L - 480; const bool isz = L < 448, isk = L < 480;
        const int pmk = Lk & 3, pnk = Lk >> 2, pmv = Lv & 3, pnv = Lv >> 2;
        pm = isz ? pm : (isk ? pmk : pmv); pn = isz ? pn : (isk ? pnk : pnv);
        const char* a0 = isz ? ws + WS_XN : mn;
        const char* b0 = isz ? wl + WO_IN : (isk ? wl + WO_KV : wl + WO_KV + (size_t)D * D * 2);
        u.A = a0 + (size_t)pm * 256 * D * 2; u.B = b0 + (size_t)pn * 256 * D * 2;
        u.O = (void*)(isz ? ws + WS_BIG + BO_Z : (isk ? ws + WS_KB : ws + WS_VB)); u.ldo = isz ? NIN : D;
        u.pm = pm; u.pn = pn; u.flag = isz && pn < 8; u.nt = D / 64; return true;
    }
};
template <bool GU_FIRST> struct SchedGU {
    const char* ws; const char* wl; int G, c;
    __device__ __forceinline__ bool next(int i, pg8::Unit& u) const {
        const int L0 = i * G + c; if (L0 >= 512) return false;
        const bool first = L0 < 256, is_tile = GU_FIRST ? !first : first; const int L = first ? L0 : L0 - 256;
        if (is_tile) { int pm, pn; pg8::tile_order(L, M / 256, D / 256, pm, pn);
            u.A = ws + WS_BIG + BO_Y + (size_t)pm * 256 * D * 2; u.B = wl + WO_OUT + (size_t)pn * 256 * D * 2; u.O = (void*)(ws + WS_HB); u.ldo = D; u.pm = pm; u.pn = pn; u.flag = 0; u.nt = D / 64; return true; }
        const int L2 = L;
        const bool isg = L2 < 128; const int j = L2 & 127, bh = j >> 3, t = j & 7, b = bh >> 2, h = bh & 3;
        const char* kv = ws + (isg ? WS_KB : WS_VB) + ((size_t)(b * MEM) * D + h * XD) * 2;
        const char* w = wl + (isg ? WO_Q : WO_O) + ((size_t)(t * 256) * D + h * XD) * 2;
        u.A = isg ? kv : w; u.B = isg ? w : kv;
        u.O = (void*)(isg ? ws + WS_BIG + BO_GT : ws + WS_BIG + BO_UT + (size_t)b * D * (XH * MEM) * 2);
        u.ldo = isg ? D : XH * MEM; u.pm = isg ? bh : t; u.pn = isg ? t : h; u.flag = 0; u.nt = XD / 64; return true;
    }
};
struct SchedS {
    const char* XN; const char* GT; void* P; int G, c;
    __device__ __forceinline__ bool next(int i, pg8::Unit& u) const {
        const int L = i * G + c; if (L >= 128) return false;
        const int b = L >> 5, h = (L >> 3) & 3, rp = L & 7;
        u.A = XN + (size_t)(b * SEQ + rp * 256) * D * 2; u.B = GT + (size_t)((b * 4 + h) * 256) * D * 2; u.O = P; u.ldo = XH * MEM; u.pm = b * 8 + rp; u.pn = h; u.flag = 0; u.nt = D / 64; return true;
    }
};
struct SchedO {
    const char* P; const char* UT; void* HB; int G, c;
    __device__ __forceinline__ bool next(int i, pg8::Unit& u) const {
        const int L = i * G + c; if (L >= 256) return false;
        int pm, pn; pg8::tile_order(L, 32, 8, pm, pn); const int b = pm >> 3;
        u.A = P + (size_t)pm * 256 * (XH * MEM) * 2; u.B = UT + ((size_t)b * D + pn * 256) * (XH * MEM) * 2; u.O = HB; u.ldo = D; u.pm = pm; u.pn = pn; u.flag = 0; u.nt = (XH * MEM) / 64; return true;
    }
};

struct Frame {
    LAS unsigned char* lds; int tid, lane, wave, vcu, G;
    decltype(__builtin_amdgcn_kernarg_segment_ptr()) kp; float* out; unsigned char* ws;
};
__device__ __forceinline__ const float* inp(const Frame& F, int i) { asm volatile("" : "+s"(i)); return (const float*)*(const GAS float* const*)((const char*)F.kp + 8 * i); }

__device__ __forceinline__ void refresh(Frame& F) { F.tid = fresh_tid(); F.lane = F.tid & 63; F.wave = __builtin_amdgcn_readfirstlane(F.tid >> 6); }
constexpr int T_IN = (D / 64) * (NIN / 64), T_SQ = (D / 64) * (D / 64), T_UP = (D / 64) * (FF / 64);
constexpr int T_TR = T_IN + 4 * T_SQ + 2 * T_UP;
constexpr int U_LAYER = T_TR * 2, U_ALL = NL * U_LAYER;
constexpr int U_IDLE_SHARE = 14336;
constexpr int U_IDLE_SHARE_L1 = 16384;
constexpr int U_L1_IN_S0 = 8192;
constexpr int U_EARLY = (T_IN + 4 * T_SQ) * 2;
struct TUnit { const float* src; bf16_t* dst; int N, K; };
__device__ __forceinline__ TUnit p0_unit(const Frame& F, int u) {
    const int g = u >> 3, kt = (u >> 1) & 3, hh = u & 1, l = g / (T_TR / 4); int r = g % (T_TR / 4); unsigned char* wl = F.ws + WS_W + (size_t)l * W_LAYER;
    int idx, K = D, N = D, row_off = 0; size_t wo, lsz = (size_t)D * D;
    if (r < T_IN / 4) { idx = 4; N = NIN; wo = WO_IN; lsz = (size_t)D * NIN; }
    else if ((r -= T_IN / 4) < T_SQ / 4) { idx = 5; wo = WO_OUT; }
    else if ((r -= T_SQ / 4) < T_SQ / 4) { idx = 19; wo = WO_KV; }
    else if ((r -= T_SQ / 4) < T_SQ / 4) { idx = 20; wo = WO_KV; row_off = D; }
    else if ((r -= T_SQ / 4) < T_SQ / 4) { idx = 21; wo = WO_O; }
    else if ((r -= T_SQ / 4) < T_UP / 4) { idx = 24; N = FF; wo = WO_UP; lsz = (size_t)D * FF; }
    else { r -= T_UP / 4; idx = 25; K = FF; wo = WO_DN; lsz = (size_t)D * FF; }
    const int nblk = N / 64, k0 = 256 * (r / nblk) + 64 * kt, n0 = 64 * (r % nblk) + 32 * hh;
    TUnit t; t.src = inp(F, idx) + (size_t)l * lsz + (size_t)k0 * N + n0; t.dst = (bf16_t*)(wl + wo) + (size_t)(row_off + n0) * K + k0; t.N = N; t.K = K; return t;
}
__device__ __forceinline__ void p0_unit_dma(const TUnit& t, int lane, LAS unsigned char* buf) {
#pragma unroll
    for (int i = 0; i < 8; ++i)
        __builtin_amdgcn_global_load_lds((const unsigned*)(t.src + (size_t)(8 * i + (lane >> 3)) * t.N + 4 * ((lane & 7) ^ i)), (LAS unsigned*)(buf + i * 1024), 16, 0,   2);
}
__device__ __forceinline__ void p0_unit_out(const TUnit& t, int lane, const LAS float* scr) {
    const int kc = lane & 7;
#pragma unroll
    for (int j = 0; j < 4; ++j) { const int n = (lane >> 3) + 8 * j; const LAS float* s = scr + (8 * kc) * 32 + (n ^ (4 * kc));
        u32x4 o; o.x = cvt_pk_bf16(s[0 * 32], s[1 * 32]); o.y = cvt_pk_bf16(s[2 * 32], s[3 * 32]); o.z = cvt_pk_bf16(s[4 * 32], s[5 * 32]); o.w = cvt_pk_bf16(s[6 * 32], s[7 * 32]);
        *(GAS u32x4*)(t.dst + (size_t)n * t.K + 8 * kc) = o; }
}
__device__ __forceinline__ void p0_convert(Frame& F, int w0, int nw, int lo, int hi) {
    LAS unsigned char* base = F.lds + F.wave * 16384;
    int u = lo + w0; if (u >= hi) return;
    int b = 0;
    TUnit tc = p0_unit(F, u);
    p0_unit_dma(tc, F.lane, base);
    for (; u < hi; u += nw) {
        const bool more = u + nw < hi;
        TUnit tn = tc;
        if (more) { tn = p0_unit(F, u + nw); p0_unit_dma(tn, F.lane, base + (b ^ 1) * 8192); asm volatile("s_waitcnt vmcnt(8)" ::: "memory"); }
        else asm volatile("s_waitcnt vmcnt(0)" ::: "memory");
        p0_unit_out(tc, F.lane, (const LAS float*)(base + b * 8192));
        LDS_WAIT(); asm volatile("" ::: "memory");
        tc = tn; b ^= 1;
    }
}
__device__ __forceinline__ void p0_plain(Frame& F, int gw, int ngw, int l0, int l1) {
    for (int c = l0 * (D * D / 8) + gw * 64 + F.lane; c < l1 * (D * D / 8); c += ngw * 64) {
        const int l = c / (D * D / 8), r = c % (D * D / 8);
        const GAS f32x4* sp = (const GAS f32x4*)(inp(F, 18) + (size_t)l * D * D) + 2 * r; const f32x4 a = __builtin_nontemporal_load(sp), bq = __builtin_nontemporal_load(sp + 1);
        u32x4 o; o.x = cvt_pk_bf16(a.x, a.y); o.y = cvt_pk_bf16(a.z, a.w); o.z = cvt_pk_bf16(bq.x, bq.y); o.w = cvt_pk_bf16(bq.z, bq.w);
        ((GAS u32x4*)(F.ws + WS_W + (size_t)l * W_LAYER + WO_Q))[r] = o; }
}
__device__ __forceinline__ void rms_row_to_bf16(const float* xrow, const float* g, bf16_t* orow, float* cp, int lane) {
    const GAS f32x4* xr = (const GAS f32x4*)xrow + lane; f32x4 v[8]; float s = 0.f;
#pragma unroll
    for (int j = 0; j < 8; ++j) { v[j] = xr[64 * j]; s += (v[j].x * v[j].x + v[j].y * v[j].y) + (v[j].z * v[j].z + v[j].w * v[j].w); }
    const float rs = 1.f / sqrtf(wave_sum(s) * (1.f / D) + RMS_EPS);
    if (cp) { GAS f32x4* c4 = (GAS f32x4*)cp + lane;
#pragma unroll
        for (int j = 0; j < 8; ++j) c4[64 * j] = v[j]; }
    const GAS f32x4* g4 = (const GAS f32x4*)g + lane; GAS u32x2* o8 = (GAS u32x2*)orow + lane;
#pragma unroll
    for (int j = 0; j < 8; ++j) { const f32x4 gg = g4[64 * j]; u32x2 w; w.x = cvt_pk_bf16(v[j].x * rs * gg.x, v[j].y * rs * gg.y); w.y = cvt_pk_bf16(v[j].z * rs * gg.z, v[j].w * rs * gg.w); o8[64 * j] = w; }
}
__device__ __forceinline__ void p0_memnorm(Frame& F, int gw, int ngw, int l0, int l1) {
    for (int m = l0 * MM + gw; m < l1 * MM; m += ngw) { const int l = m / MM, r = m % MM;
        rms_row_to_bf16(inp(F, 1) + (size_t)r * D, inp(F, 16) + l * D, (bf16_t*)(F.ws + WS_MN) + (size_t)m * D, nullptr, F.lane); }
}
__device__ __forceinline__ void p0_prologue(Frame& F) {
    refresh(F);
    const int gw = F.vcu * NWAVES + F.wave, NGW = F.G * NWAVES;
    for (int l = 0; l < NL; ++l) p0_convert(F, gw, NGW, l * U_LAYER, (F.G == 256) ? l * U_LAYER + U_EARLY - (l == 1 ? U_L1_IN_S0 : 0) : (l + 1) * U_LAYER);
    p0_plain(F, gw, NGW, 0, (F.G == 256) ? 1 : NL);
    for (int r = gw; r < NL * PG * 128; r += NGW) {
        const float* wp = inp(F, 9) + (size_t)(r >> 7) * 128 * 128 + (r & 127);
        ((GAS unsigned*)(F.ws + WS_WPT))[(size_t)r * 64 + F.lane] = cvt_pk_bf16(wp[(2 * F.lane) * 128], wp[(2 * F.lane + 1) * 128]); }
    for (int r = gw; r < NL * GH * CH; r += NGW) {
        const int t = r & 127; const f32x2 w2 = *(const GAS f32x2*)(inp(F, 7) + (size_t)r * CH + 2 * F.lane);
        ((GAS unsigned*)(F.ws + WS_WSM))[(size_t)r * 64 + F.lane] = cvt_pk_bf16(2 * F.lane <= t ? w2.x : 0.f, 2 * F.lane + 1 <= t ? w2.y : 0.f); }
    p0_memnorm(F, gw, NGW, 0, NL);
    for (int i = gw * 64 + F.lane; i < 2 * M * 8; i += NGW * 64) __hip_atomic_store((GAS unsigned long long*)(F.ws + WS_GR) + i, 0ull, __ATOMIC_RELAXED, __HIP_MEMORY_SCOPE_AGENT);
    for (int m0 = gw; m0 < M; m0 += 4 * NGW) {
        f32x4 v[4][8];
#pragma unroll
        for (int r = 0; r < 4; ++r) { const int m = m0 + r * NGW; if (m < M) { const GAS f32x4* xr = (const GAS f32x4*)(inp(F, 0) + (size_t)m * D) + F.lane;
#pragma unroll
            for (int j = 0; j < 8; ++j) v[r][j] = xr[64 * j]; } }
#pragma unroll
        for (int r = 0; r < 4; ++r) { const int m = m0 + r * NGW; if (m < M) { float s = 0.f;
#pragma unroll
            for (int j = 0; j < 8; ++j) s += (v[r][j].x * v[r][j].x + v[r][j].y * v[r][j].y) + (v[r][j].z * v[r][j].z + v[r][j].w * v[r][j].w);
            { GAS u32x2* xh = (GAS u32x2*)((unsigned short*)(F.ws + WS_XH) + (size_t)m * D) + F.lane;
#pragma unroll
              for (int j = 0; j < 8; ++j) { u32x2 w; w.x = pk_f16(v[r][j].x, v[r][j].y); w.y = pk_f16(v[r][j].z, v[r][j].w); xh[64 * j] = w; } }
            const float rs = 1.f / sqrtf(wave_sum(s) * (1.f / D) + RMS_EPS);
            const GAS f32x4* g4 = (const GAS f32x4*)inp(F, 2) + F.lane; GAS u32x2* o8 = (GAS u32x2*)((bf16_t*)(F.ws + WS_XN) + (size_t)m * D) + F.lane;
#pragma unroll
            for (int j = 0; j < 8; ++j) { const f32x4 gg = g4[64 * j]; u32x2 w; w.x = cvt_pk_bf16(v[r][j].x * rs * gg.x, v[r][j].y * rs * gg.y); w.y = cvt_pk_bf16(v[r][j].z * rs * gg.z, v[r][j].w * rs * gg.w); o8[64 * j] = w; } } }
    }
}

template <bool IN_F32, bool OUT_F32>
__device__ __forceinline__ void norm_pass(Frame& F, const float* g_post, const float* g_pre) {
    refresh(F);
    const int gw = F.vcu * NWAVES + F.wave, NGW = F.G * NWAVES;
    const bf16_t* HB = (const bf16_t*)(F.ws + WS_HB); bf16_t* XN = (bf16_t*)(F.ws + WS_XN); unsigned short* XH = (unsigned short*)(F.ws + WS_XH);
    constexpr int NR = IN_F32 ? 2 : 4;
    for (int m0 = gw; m0 < M; m0 += NR * NGW) {
        u32x2 hw[NR][8]; f32x4 xf[IN_F32 ? NR : 1][8]; u32x2 xw[IN_F32 ? 1 : NR][8];
#pragma unroll
        for (int r = 0; r < NR; ++r) { const int m = m0 + r * NGW; if (m < M) {
            const GAS u32x2* hr = (const GAS u32x2*)(HB + (size_t)m * D) + F.lane;
            if constexpr (IN_F32) { const GAS f32x4* xi = (const GAS f32x4*)(inp(F, 0) + (size_t)m * D) + F.lane;
#pragma unroll
                for (int j = 0; j < 8; ++j) xf[IN_F32 ? r : 0][j] = __builtin_nontemporal_load(xi + 64 * j); }
            else { const GAS u32x2* xi = (const GAS u32x2*)(XH + (size_t)m * D) + F.lane;
#pragma unroll
                for (int j = 0; j < 8; ++j) xw[IN_F32 ? 0 : r][j] = __builtin_nontemporal_load(xi + 64 * j); }
#pragma unroll
            for (int j = 0; j < 8; ++j) hw[r][j] = __builtin_nontemporal_load(hr + 64 * j); } }
#pragma unroll
        for (int r = 0; r < NR; ++r) { const int m = m0 + r * NGW; if (m < M) {
            const GAS f32x4* gp = (const GAS f32x4*)g_post + F.lane;
            f32x4 h[8], x[8]; float s = 0.f;
#pragma unroll
            for (int j = 0; j < 8; ++j) { const u32x2 w = hw[r][j]; h[j] = (f32x4){bf_lo(w.x), bf_hi(w.x), bf_lo(w.y), bf_hi(w.y)}; s += (h[j].x * h[j].x + h[j].y * h[j].y) + (h[j].z * h[j].z + h[j].w * h[j].w);
                if constexpr (IN_F32) x[j] = xf[IN_F32 ? r : 0][j]; else { const f32x2 a = unpk_f16(xw[IN_F32 ? 0 : r][j].x), b = unpk_f16(xw[IN_F32 ? 0 : r][j].y); x[j] = (f32x4){a.x, a.y, b.x, b.y}; } }
            const float rs = 1.f / sqrtf(wave_sum(s) * (1.f / D) + RMS_EPS); float s2 = 0.f;
#pragma unroll
            for (int j = 0; j < 8; ++j) { const f32x4 g = gp[64 * j]; x[j] = x[j] + h[j] * rs * g;
                if constexpr (OUT_F32) ((GAS f32x4*)(F.out + (size_t)m * D) + F.lane)[64 * j] = x[j];
                else { u32x2 w; w.x = pk_f16(x[j].x, x[j].y); w.y = pk_f16(x[j].z, x[j].w); ((GAS u32x2*)(XH + (size_t)m * D) + F.lane)[64 * j] = w; }
                s2 += (x[j].x * x[j].x + x[j].y * x[j].y) + (x[j].z * x[j].z + x[j].w * x[j].w); }
            if (g_pre) {
                const float rs2 = 1.f / sqrtf(wave_sum(s2) * (1.f / D) + RMS_EPS);
                const GAS f32x4* g4 = (const GAS f32x4*)g_pre + F.lane; GAS u32x2* o8 = (GAS u32x2*)(XN + (size_t)m * D) + F.lane;
#pragma unroll
                for (int j = 0; j < 8; ++j) { const f32x4 gg = g4[64 * j]; u32x2 w; w.x = cvt_pk_bf16(x[j].x * rs2 * gg.x, x[j].y * rs2 * gg.y); w.y = cvt_pk_bf16(x[j].z * rs2 * gg.z, x[j].w * rs2 * gg.w); o8[64 * j] = w; }
            } } }
    }
}

constexpr int LDP = 136;
__device__ __forceinline__ void small_mma(const LAS bf16_t* Tm, const LAS bf16_t* Dm, int wave, int fr, int fq, f32x4 (&acc)[8]) {
#pragma unroll
    for (int dt = 0; dt < 8; ++dt) acc[dt] = (f32x4){0.f, 0.f, 0.f, 0.f};
#pragma unroll
    for (int k = 0; k < 4; ++k) {
        const bf16x8 y = *(const LAS bf16x8*)(Tm + (16 * wave + fr) * LDP + 32 * k + 8 * fq);
#pragma unroll
        for (int dt = 0; dt < 8; ++dt) { const bf16x8 x = *(const LAS bf16x8*)(Dm + (32 * (dt >> 1) + 8 * (fr >> 2) + 4 * (dt & 1) + (fr & 3)) * LDP + 32 * k + 8 * fq);
            acc[dt] = __builtin_amdgcn_mfma_f32_16x16x32_bf16(x, y, acc[dt], 0, 0, 0); }
    }
}
__device__ __forceinline__ void gmlp_pair(Frame& F, int l, int pair) {
    refresh(F);
    const int bc = pair >> 3, h = pair & 7, tid = F.tid;
    LAS bf16_t* Wm = (LAS bf16_t*)F.lds; LAS bf16_t* vT0 = Wm + 128 * LDP; LAS bf16_t* vT1 = vT0 + 128 * LDP;
    const bf16_t* Z = (const bf16_t*)(F.ws + WS_BIG + BO_Z); bf16_t* Y = (bf16_t*)(F.ws + WS_BIG + BO_Y);
    const int t = tid >> 2, q4 = tid & 3;
    const int fr = F.lane & 15, fq = F.lane >> 4;
    const int tt = 16 * F.wave + fr;
    u32x4 uw[2][4];
#pragma unroll
    for (int p2 = 0; p2 < 2; ++p2) { const bf16_t* urow = Z + (size_t)((bc + 32 * p2) * CH + tt) * NIN + h * HD + 8 * fq;
#pragma unroll
        for (int j = 0; j < 4; ++j) uw[p2][j] = *(const GAS u32x4*)(urow + 32 * j); }
    {
        const GAS u32x4* wsrc = (const GAS u32x4*)((const bf16_t*)(F.ws + WS_WSM) + ((size_t)(l * GH + h) * CH + t) * CH + q4 * 32);
#pragma unroll
        for (int j = 0; j < 4; ++j) *(LAS u32x4*)(Wm + t * LDP + q4 * 32 + 8 * j) = wsrc[j];
    }
    {
        const GAS f32x4* gv4 = (const GAS f32x4*)(inp(F, 6) + (l * GH + h) * HD + q4 * 32); float gv[32];
#pragma unroll
        for (int i = 0; i < 8; ++i) { const f32x4 g = gv4[i]; gv[4 * i] = g.x; gv[4 * i + 1] = g.y; gv[4 * i + 2] = g.z; gv[4 * i + 3] = g.w; }
        u32x4 vw[2][4];
#pragma unroll
        for (int p2 = 0; p2 < 2; ++p2) { const GAS u32x4* vsrc = (const GAS u32x4*)(Z + (size_t)((bc + 32 * p2) * CH + t) * NIN + GW + h * HD + q4 * 32);
#pragma unroll
            for (int j = 0; j < 4; ++j) vw[p2][j] = vsrc[j]; }
#pragma unroll
        for (int p2 = 0; p2 < 2; ++p2) { LAS bf16_t* vT = p2 ? vT1 : vT0;
            float v[32]; float sum = 0.f;
#pragma unroll
            for (int j = 0; j < 4; ++j) { const u32x4 w = vw[p2][j];
                v[8 * j + 0] = bf_lo(w.x); v[8 * j + 1] = bf_hi(w.x); v[8 * j + 2] = bf_lo(w.y); v[8 * j + 3] = bf_hi(w.y); v[8 * j + 4] = bf_lo(w.z); v[8 * j + 5] = bf_hi(w.z); v[8 * j + 6] = bf_lo(w.w); v[8 * j + 7] = bf_hi(w.w); }
#pragma unroll
            for (int i = 0; i < 32; ++i) sum += v[i];
            sum += lx1(sum); sum += lx2(sum);
            const float mu = sum * (1.f / HD); float q = 0.f;
#pragma unroll
            for (int i = 0; i < 32; ++i) { v[i] -= mu; q += v[i] * v[i]; }
            q += lx1(q); q += lx2(q);
            const float rs = 1.f / sqrtf(q * (1.f / HD) + LN_EPS);
#pragma unroll
            for (int i = 0; i < 32; i += 2) { const unsigned w = cvt_pk_bf16(v[i] * rs * gv[i], v[i + 1] * rs * gv[i + 1]);
                vT[(q4 * 32 + i) * LDP + t] = (bf16_t)(w & 0xffffu); vT[(q4 * 32 + i + 1) * LDP + t] = (bf16_t)(w >> 16); } }
    }
    __syncthreads();
    f32x4 acc0[8], acc1[8];
#pragma unroll
    for (int dt = 0; dt < 8; ++dt) { acc0[dt] = (f32x4){0.f, 0.f, 0.f, 0.f}; acc1[dt] = (f32x4){0.f, 0.f, 0.f, 0.f}; }
#pragma unroll
    for (int k = 0; k < 4; ++k) {
        const bf16x8 y = *(const LAS bf16x8*)(Wm + (16 * F.wave + fr) * LDP + 32 * k + 8 * fq);
#pragma unroll
        for (int dt = 0; dt < 8; ++dt) { const int drow = (32 * (dt >> 1) + 8 * (fr >> 2) + 4 * (dt & 1) + (fr & 3)) * LDP + 32 * k + 8 * fq;
            acc0[dt] = __builtin_amdgcn_mfma_f32_16x16x32_bf16(*(const LAS bf16x8*)(vT0 + drow), y, acc0[dt], 0, 0, 0);
            acc1[dt] = __builtin_amdgcn_mfma_f32_16x16x32_bf16(*(const LAS bf16x8*)(vT1 + drow), y, acc1[dt], 0, 0, 0); }
    }
    {
        const float bsv = inp(F, 8)[(l * GH + h) * CH + tt];
#pragma unroll
        for (int p2 = 0; p2 < 2; ++p2) { bf16_t* yrow = Y + (size_t)((bc + 32 * p2) * CH + tt) * D + h * HD + 8 * fq;
#pragma unroll
            for (int j = 0; j < 4; ++j) { const f32x4 a = p2 ? acc1[2 * j] : acc0[2 * j], b = p2 ? acc1[2 * j + 1] : acc0[2 * j + 1]; const u32x4 uu = uw[p2][j];
                u32x4 o; o.x = cvt_pk_bf16(bf_lo(uu.x) * (a[0] + bsv), bf_hi(uu.x) * (a[1] + bsv)); o.y = cvt_pk_bf16(bf_lo(uu.y) * (a[2] + bsv), bf_hi(uu.y) * (a[3] + bsv));
                o.z = cvt_pk_bf16(bf_lo(uu.z) * (b[0] + bsv), bf_hi(uu.z) * (b[1] + bsv)); o.w = cvt_pk_bf16(bf_lo(uu.w) * (b[2] + bsv), bf_hi(uu.w) * (b[3] + bsv));
                *(GAS u32x4*)(yrow + 32 * j) = o; } }
    }
    __syncthreads();
}
struct PoolRegs { u32x4 z[5]; u32x4 w[4]; };
__device__ __forceinline__ void pool_load(Frame& F, int l, int unit, PoolRegs& R) {
    refresh(F);
    const int bc = unit >> 2, g = unit & 3, row0 = bc * CH, cseq = bc & 15, tid = F.tid;
    const bf16_t* Z = (const bf16_t*)(F.ws + WS_BIG + BO_Z);
#pragma unroll
    for (int k = 0; k < 5; ++k) { const int ch = tid + 512 * k, i = ch >> 4, c16 = ch & 15; R.z[k] = (u32x4){0u, 0u, 0u, 0u};
        if (ch < 144 * 16 && (cseq > 0 || i >= 16)) R.z[k] = *(const GAS u32x4*)(Z + (size_t)(row0 - 16 + i) * NIN + 2 * GW + g * 128 + c16 * 8); }
    const int d = tid >> 2, q4 = tid & 3; const GAS u32x4* wsrc = (const GAS u32x4*)((const bf16_t*)(F.ws + WS_WPT) + ((size_t)(l * PG + g) * 128 + d) * 128 + q4 * 32);
#pragma unroll
    for (int j = 0; j < 4; ++j) R.w[j] = wsrc[j];
}
__device__ __forceinline__ void pool_unit(Frame& F, int l, int unit, const PoolRegs& R) {
    refresh(F);
    const int bc = unit >> 2, g = unit & 3, row0 = bc * CH, cseq = bc & 15, w = 2 << g, tid = F.tid;
    LAS unsigned* Pt = (LAS unsigned*)F.lds;
    LAS bf16_t* Pl = (LAS bf16_t*)(F.lds + 36864); LAS bf16_t* WpT = Pl + 128 * LDP;
    bf16_t* Y = (bf16_t*)(F.ws + WS_BIG + BO_Y);
#pragma unroll
    for (int k = 0; k < 5; ++k) { const int ch = tid + 512 * k, i = ch >> 4, c16 = ch & 15; if (ch < 144 * 16) *(LAS u32x4*)(Pt + i * 64 + c16 * 4) = R.z[k]; }
    {
        const int d = tid >> 2, q4 = tid & 3;
#pragma unroll
        for (int j = 0; j < 4; ++j) *(LAS u32x4*)(WpT + d * LDP + q4 * 32 + 8 * j) = R.w[j];
    }
    __syncthreads();
    {
        const int cp = tid & 63, tg = tid >> 6, i0 = tg * 16 + 16;
        float s0 = 0.f, s1 = 0.f;
        for (int j = 1; j < w; ++j) { const unsigned d = Pt[(i0 - j) * 64 + cp]; s0 += bf_lo(d); s1 += bf_hi(d); }
#pragma unroll
        for (int tt = 0; tt < 16; ++tt) { const int t = tg * 16 + tt, i = t + 16, pos = cseq * CH + t;
            const unsigned self = Pt[i * 64 + cp]; s0 += bf_lo(self); s1 += bf_hi(self);
            const float inv = 1.f / (float)((pos + 1) < w ? (pos + 1) : w);
            ((LAS unsigned*)Pl)[t * (LDP / 2) + cp] = cvt_pk_bf16(s0 * inv - bf_lo(self), s1 * inv - bf_hi(self));
            const unsigned old = Pt[(i - w + 1) * 64 + cp]; s0 -= bf_lo(old); s1 -= bf_hi(old); }
    }
    __syncthreads();
    const int fr = F.lane & 15, fq = F.lane >> 4;
    f32x4 acc[8];
    small_mma(Pl, WpT, F.wave, fr, fq, acc);
    {
        const int tt = 16 * F.wave + fr; const float* sp = inp(F, 10) + l * PW + g * 128 + 8 * fq; bf16_t* yrow = Y + (size_t)(row0 + tt) * D + GW + g * 128 + 8 * fq;
#pragma unroll
        for (int j = 0; j < 4; ++j) { const f32x4 s0 = *(const GAS f32x4*)(sp + 32 * j), s1 = *(const GAS f32x4*)(sp + 32 * j + 4); const f32x4 a = acc[2 * j], b = acc[2 * j + 1];
            u32x4 o; o.x = cvt_pk_bf16(a[0] * s0.x, a[1] * s0.y); o.y = cvt_pk_bf16(a[2] * s0.z, a[3] * s0.w); o.z = cvt_pk_bf16(b[0] * s1.x, b[1] * s1.y); o.w = cvt_pk_bf16(b[2] * s1.z, b[3] * s1.w);
            *(GAS u32x4*)(yrow + 32 * j) = o; }
    }
    __syncthreads();
}
constexpr int CT = 32, CR = CT + CK - 1;
template <int I> __device__ __forceinline__ void conv_taps(float (&acc)[CT], const float (&wj)[CK], const LAS bf16_t* Hc) {
    if constexpr (I < CR) {
        const float hv = __builtin_bit_cast(float, (unsigned)Hc[I * 512] << 16);
        constexpr int T0 = (I - (CK - 1) > 0) ? I - (CK - 1) : 0, T1 = (I < CT - 1) ? I : CT - 1;
#pragma unroll
        for (int t = T0; t <= T1; ++t) acc[t] += wj[I - t] * hv;
        conv_taps<I + 1>(acc, wj, Hc);
    }
}
constexpr int CONV_NP = CR * 64, CONV_NK = (CONV_NP + 511) / 512;
struct ConvRegs { u32x4 cv[CONV_NK], cg[CONV_NK]; };
__device__ __forceinline__ void conv_load(Frame& F, int unit, ConvRegs& R) {
    refresh(F);
    const int row0 = unit * CT, pos0 = row0 & (SEQ - 1), c = F.tid;
    const bf16_t* Z = (const bf16_t*)(F.ws + WS_BIG + BO_Z);
#pragma unroll
    for (int k = 0; k < CONV_NK; ++k) { const int p = (c + 512 * k < CONV_NP) ? c + 512 * k : c; const int i = p >> 6, grp = p & 63; const bool ok = (pos0 - (CK - 1) + i) >= 0;
        const bf16_t* zr = Z + (size_t)(ok ? row0 - (CK - 1) + i : row0) * NIN + 2 * GW + PW + 8 * grp;
        R.cv[k] = *(const GAS u32x4*)zr; R.cg[k] = *(const GAS u32x4*)(zr + CW); }
}
__device__ __forceinline__ void conv_unit(Frame& F, int l, int unit, const float (&wj)[CK], const ConvRegs& R) {
    refresh(F);
    const int row0 = unit * CT, pos0 = row0 & (SEQ - 1), c = F.tid;
    bf16_t* Y = (bf16_t*)(F.ws + WS_BIG + BO_Y);
    LAS bf16_t* H = (LAS bf16_t*)F.lds;
    LAS float* CV = (LAS float*)(F.lds + CR * 512 * 2);
    {
        constexpr int NP = CONV_NP, NK = CONV_NK;
        const u32x4 (&cv)[NK] = R.cv; const u32x4 (&cg)[NK] = R.cg;
#pragma unroll
        for (int k = 0; k < NK; ++k) { const int p = c + 512 * k; if (p < NP) { const int i = p >> 6, grp = p & 63; const float ok = (pos0 - (CK - 1) + i) >= 0 ? 1.f : 0.f;
            u32x4 o;
            o.x = cvt_pk_bf16(ok * bf_lo(cv[k].x) * fast_sigmoid(bf_lo(cg[k].x)), ok * bf_hi(cv[k].x) * fast_sigmoid(bf_hi(cg[k].x)));
            o.y = cvt_pk_bf16(ok * bf_lo(cv[k].y) * fast_sigmoid(bf_lo(cg[k].y)), ok * bf_hi(cv[k].y) * fast_sigmoid(bf_hi(cg[k].y)));
            o.z = cvt_pk_bf16(ok * bf_lo(cv[k].z) * fast_sigmoid(bf_lo(cg[k].z)), ok * bf_hi(cv[k].z) * fast_sigmoid(bf_hi(cg[k].z)));
            o.w = cvt_pk_bf16(ok * bf_lo(cv[k].w) * fast_sigmoid(bf_lo(cg[k].w)), ok * bf_hi(cv[k].w) * fast_sigmoid(bf_hi(cg[k].w)));
            *(LAS u32x4*)(H + i * 512 + 8 * grp) = o; } }
    }
    __syncthreads();
    float acc[CT];
#pragma unroll
    for (int t = 0; t < CT; ++t) acc[t] = 0.f;
    conv_taps<0>(acc, wj, H + c);
    const float bd = inp(F, 12)[l * CW + c];
#pragma unroll
    for (int t = 0; t < CT; ++t) CV[t * 512 + c] = acc[t] + bd;
    __syncthreads();
    const GAS f32x4* lg = (const GAS f32x4*)(inp(F, 13) + l * CW) + 2 * F.lane; const GAS f32x4* lb = (const GAS f32x4*)(inp(F, 14) + l * CW) + 2 * F.lane;
    const f32x4 g0 = lg[0], g1 = lg[1], b0 = lb[0], b1 = lb[1];
#pragma unroll
    for (int k = 0; k < CT / 8; ++k) { const int t = (CT / 8) * F.wave + k;
        f32x4 a = *(const LAS f32x4*)(CV + t * 512 + 8 * F.lane), b = *(const LAS f32x4*)(CV + t * 512 + 8 * F.lane + 4);
        const float mu = wave_sum((a.x + a.y) + (a.z + a.w) + (b.x + b.y) + (b.z + b.w)) * (1.f / CW);
        a = a - mu; b = b - mu;
        const float var = wave_sum((a.x * a.x + a.y * a.y) + (a.z * a.z + a.w * a.w) + (b.x * b.x + b.y * b.y) + (b.z * b.z + b.w * b.w)) * (1.f / CW);
        const float rs = 1.f / sqrtf(var + LN_EPS);
        a = a * rs * g0 + b0; b = b * rs * g1 + b1;
        u32x4 o; o.x = cvt_pk_bf16(a.x * fast_sigmoid(a.x), a.y * fast_sigmoid(a.y)); o.y = cvt_pk_bf16(a.z * fast_sigmoid(a.z), a.w * fast_sigmoid(a.w));
        o.z = cvt_pk_bf16(b.x * fast_sigmoid(b.x), b.y * fast_sigmoid(b.y)); o.w = cvt_pk_bf16(b.z * fast_sigmoid(b.z), b.w * fast_sigmoid(b.w));
        *(GAS u32x4*)(Y + (size_t)(row0 + t) * D + GW + PW + 8 * F.lane) = o; }
    __syncthreads();
}
static_assert((M / CH) * GH / 2 == 256 && (M / CH) * PG == 256 && M / CT == 256, "the three mixers have 256 units each");
__device__ __forceinline__ void mixer_phase(Frame& F, int l) {
    float wj[CK]; { const float* wdw = inp(F, 11) + (size_t)l * CK * CW + fresh_tid();
#pragma unroll
        for (int j = 0; j < CK; ++j) wj[j] = wdw[j * CW]; }
    for (int u = F.vcu; u < 256; u += F.G) {
        PoolRegs PR; pool_load(F, l, u, PR);
        gmlp_pair(F, l, u);
        ConvRegs CRg; conv_load(F, u, CRg);
        pool_unit(F, l, u, PR);
        conv_unit(F, l, u, wj, CRg);
    }
}

struct Args { const float* in[26]; float* out; unsigned char* ws; int stop, rep; };
__global__ void __launch_bounds__(NWAVES * 64, 2) mega_fwd(Args args) {
    extern __shared__ __attribute__((aligned(16))) unsigned char lds[];
    Frame F;
    F.lds = (LAS unsigned char*)lds;
    F.tid = threadIdx.x; F.lane = F.tid & 63; F.wave = __builtin_amdgcn_readfirstlane(F.tid >> 6);
    F.G = gridDim.x; { const int bx = blockIdx.x; F.vcu = (F.G % 8 == 0) ? (bx % 8) * (F.G / 8) + bx / 8 : bx; }
    F.kp = __builtin_amdgcn_kernarg_segment_ptr();
    F.out = args.out; F.ws = args.ws;
    for (int u = F.tid; u < (LDS_BYTES - LDSCTL_OFF) / 4; u += NWAVES * 64) ((LAS unsigned*)(F.lds + LDSCTL_OFF))[u] = 0u;
    __syncthreads();
    const XcdBarrier bar = xcd_barrier_post((unsigned*)(F.ws + WS_CTL) + CW_BAR, (volatile LAS unsigned*)(F.lds + MISC_OFF) + 8);
#define GRID_BAR() do { xcd_barrier(bar); if (++ph >= args.stop) return; } while (0)
    int ph = 0;
    const int cid0 = (int)blockIdx.x;
#define cid opaque_s(cid0)
    const char* XN = (const char*)(F.ws + WS_XN); float* HB = (float*)(F.ws + WS_HB);
    unsigned char* BIG = F.ws + WS_BIG;
    const bool fusedG = (F.G == 256);

    for (int r_ = 0; r_ < (args.rep == 0 ? 2 : 1); ++r_) p0_prologue(F);
    if (args.rep == 100) for (int r_ = 0; r_ < 50; ++r_) xcd_barrier(bar);
    GRID_BAR();
    for (int l = 0; l < NL; ++l) {
        const unsigned char* wl = F.ws + WS_W + (size_t)l * W_LAYER;
        const char* MN = (const char*)(F.ws + WS_MN) + (size_t)l * MM * D * 2;
        for (int r_ = 0; r_ < (args.rep == 1 ? 2 : 1); ++r_)
        { SchedIn S{(const char*)F.ws, (const char*)wl, MN, F.G, cid};
          pg8::gemm_phase<pg8::EpiBf16<1>, SchedIn>(F.lds, D, D, S, pg8::EpiBf16<1>{}); }
        GRID_BAR();
        for (int r_ = 0; r_ < (args.rep == 2 ? 2 : 1); ++r_) mixer_phase(F, l);
        GRID_BAR();
        if (fusedG) { SchedGU<true> S{(const char*)F.ws, (const char*)wl, F.G, cid};
            pg8::gemm_phase<pg8::EpiNorm<false>, SchedGU<true>>(F.lds, D, D, S, pg8::EpiNorm<false>{pg8::NormX{inp(F, 3) + l * D, inp(F, 15) + l * D, nullptr, F.ws, (unsigned)(6 * l + 1)}}); }
        else { SchedGU<false> S{(const char*)F.ws, (const char*)wl, F.G, cid}; pg8::gemm_phase<pg8::EpiBf16<0>, SchedGU<false>>(F.lds, D, D, S, pg8::EpiBf16<0>{});
            GRID_BAR();
            norm_pass<false, false>(F, inp(F, 3) + l * D, inp(F, 15) + l * D); }
        GRID_BAR();
        for (int r_ = 0; r_ < (args.rep == 6 ? 2 : 1); ++r_) {
        { SchedS S{XN, (const char*)(BIG + BO_GT), BIG + BO_P, F.G, cid};
          pg8::gemm_phase<pg8::EpiSoftmax, SchedS>(F.lds, D, D, S, pg8::EpiSoftmax{0.044194173824159216f * 1.44269504089f}); }
        if (F.G == 256) {
            refresh(F); const int lo = l * U_LAYER + U_EARLY, mid = lo + (l == 0 ? U_IDLE_SHARE : U_IDLE_SHARE_L1), hi = (l + 1) * U_LAYER;
            if (cid0 >= 128) { p0_convert(F, (cid0 - 128) * NWAVES + F.wave, 128 * NWAVES, lo, mid); if (l == 0) { p0_convert(F, (cid0 - 128) * NWAVES + F.wave, 128 * NWAVES, U_LAYER + U_EARLY - U_L1_IN_S0, U_LAYER + U_EARLY); p0_plain(F, (cid0 - 128) * NWAVES + F.wave, 128 * NWAVES, 1, NL); } }
            else { __syncthreads();   p0_convert(F, cid0 * NWAVES + F.wave, 128 * NWAVES, mid, hi); } }
        }
        GRID_BAR();
        { SchedO S{(const char*)(BIG + BO_P), (const char*)(BIG + BO_UT), HB, F.G, cid};
          if (fusedG) pg8::gemm_phase<pg8::EpiNorm<false>, SchedO>(F.lds, XH * MEM, XH * MEM, S, pg8::EpiNorm<false>{pg8::NormX{inp(F, 17) + l * D, inp(F, 22) + l * D, nullptr, F.ws, (unsigned)(6 * l + 3)}});
          else { pg8::gemm_phase<pg8::EpiBf16<0>, SchedO>(F.lds, XH * MEM, XH * MEM, S, pg8::EpiBf16<0>{});
            GRID_BAR();
            norm_pass<false, false>(F, inp(F, 17) + l * D, inp(F, 22) + l * D); } }
        GRID_BAR();
        for (int r_ = 0; r_ < (args.rep == 10 ? 2 : 1); ++r_)
        { typedef SchedPlain<D, D, FF, M / 256, FF / 256, D> SP; SP S{XN, (const char*)(wl + WO_UP), BIG + BO_UP, F.G, cid};
          pg8::gemm_phase<pg8::EpiBf16<2>, SP>(F.lds, D, D, S, pg8::EpiBf16<2>{}); }
        GRID_BAR();
        { typedef SchedPlain<FF, FF, D, M / 256, D / 256, FF> SP; SP S{(const char*)(BIG + BO_UP), (const char*)(wl + WO_DN), HB, F.G, cid};
          const bool more = l + 1 < NL;
          if (fusedG) { if (more) pg8::gemm_phase<pg8::EpiNorm<false>, SP>(F.lds, FF, FF, S, pg8::EpiNorm<false>{pg8::NormX{inp(F, 23) + l * D, inp(F, 2) + (l + 1) * D, nullptr, F.ws, (unsigned)(6 * l + 5)}});
                        else pg8::gemm_phase<pg8::EpiNorm<true>, SP>(F.lds, FF, FF, S, pg8::EpiNorm<true>{pg8::NormX{inp(F, 23) + l * D, nullptr, F.out, F.ws, (unsigned)(6 * l + 5)}}); }
          else { pg8::gemm_phase<pg8::EpiBf16<0>, SP>(F.lds, FF, FF, S, pg8::EpiBf16<0>{});
            GRID_BAR();
            if (more) norm_pass<false, false>(F, inp(F, 23) + l * D, inp(F, 2) + (l + 1) * D); else norm_pass<false, true>(F, inp(F, 23) + l * D, nullptr); }
          if (more) GRID_BAR(); }
    }
}


#ifndef DBG_CUT
#define DBG_CUT 6
#endif
#ifndef PROBE_REP
#define PROBE_REP -1
#endif
#if DBG_CUT < 6
namespace nv {
constexpr int D = 2048, B = 4, S = 2048, L = 2, MEM = 256, HD = 128, CH = 128;
constexpr int GW = 1024, PW = 512, CW = 512, NIN = 3584, GH = 8, PG = 4, CK = 31, XH = 4, XD = 512, FF = 8192;
constexpr int M = B * S, MM = B * MEM;
constexpr float RMS_EPS = 1e-6f, LN_EPS = 1e-5f;

__device__ __forceinline__ float gelu_tanh(float x) { const float u = 0.7978845608028654f * (x + 0.044715f * x * x * x); return 0.5f * x * (1.f + tanhf(u)); }
__device__ __forceinline__ float sigmoidf(float x) { return 1.f / (1.f + expf(-x)); }

__device__ __forceinline__ float block_sum(float v, float* red) {
    for (int o = 32; o > 0; o >>= 1) v += __shfl_xor(v, o);
    __syncthreads();
    if ((threadIdx.x & 63) == 0) red[threadIdx.x >> 6] = v;
    __syncthreads();
    float s = 0.f; for (int i = 0; i < (int)(blockDim.x >> 6); ++i) s += red[i];
    return s;
}

template <int ACC> __global__ void __launch_bounds__(256) k_rmsnorm(const float* in, const float* g, float* out, int ncols) {
    __shared__ float red[8];
    const float* r = in + (size_t)blockIdx.x * ncols; float* o = out + (size_t)blockIdx.x * ncols;
    float s = 0.f; for (int c = threadIdx.x; c < ncols; c += 256) { const float v = r[c]; s += v * v; }
    s = block_sum(s, red);
    const float rs = rsqrtf(s / ncols + RMS_EPS);
    for (int c = threadIdx.x; c < ncols; c += 256) { const float v = r[c] * rs * g[c]; if (ACC) o[c] += v; else o[c] = v; }
}

template <int EPI> __global__ void __launch_bounds__(256) k_gemm(const float* A, const float* Bm, float* C, int Mr, int N, int K, int ngelu) {
    __shared__ float As[16][65], Bs[16][65];
    const int tx = threadIdx.x & 15, ty = threadIdx.x >> 4, m0 = blockIdx.y * 64, n0 = blockIdx.x * 64;
    float acc[4][4] = {};
    for (int k0 = 0; k0 < K; k0 += 16) {
        for (int i = threadIdx.x; i < 1024; i += 256) { const int r = i >> 4, c = i & 15; As[c][r] = A[(size_t)(m0 + r) * K + k0 + c]; }
        for (int i = threadIdx.x; i < 1024; i += 256) { const int r = i >> 6, c = i & 63; Bs[r][c] = Bm[(size_t)(k0 + r) * N + n0 + c]; }
        __syncthreads();
#pragma unroll
        for (int kk = 0; kk < 16; ++kk) {
            float a[4], b[4];
#pragma unroll
            for (int i = 0; i < 4; ++i) { a[i] = As[kk][ty * 4 + i]; b[i] = Bs[kk][tx * 4 + i]; }
#pragma unroll
            for (int i = 0; i < 4; ++i)
#pragma unroll
                for (int j = 0; j < 4; ++j) acc[i][j] += a[i] * b[j];
        }
        __syncthreads();
    }
#pragma unroll
    for (int i = 0; i < 4; ++i)
#pragma unroll
        for (int j = 0; j < 4; ++j) {
            const int r = m0 + ty * 4 + i, c = n0 + tx * 4 + j; float v = acc[i][j];
            if (EPI == 1) { if (c < ngelu) v = gelu_tanh(v); }
            if (EPI == 2) { v = v > 0.f ? v * v : 0.f; }
            C[(size_t)r * N + c] = v;
        }
}

__global__ void __launch_bounds__(256) k_gmlp(const float* z, const float* gv, const float* ws, const float* bs, float* y) {
    __shared__ float v[128][129];
    const int cb = blockIdx.x, h = blockIdx.y, row0 = cb * CH, tid = threadIdx.x;
    for (int i = tid; i < 128 * 128; i += 256) { const int s = i >> 7, d = i & 127; v[s][d] = z[(size_t)(row0 + s) * NIN + GW + h * HD + d]; }
    __syncthreads();
    if (tid < 128) {
        float mu = 0.f; for (int d = 0; d < 128; ++d) mu += v[tid][d]; mu *= (1.f / 128.f);
        float var = 0.f; for (int d = 0; d < 128; ++d) { const float e = v[tid][d] - mu; var += e * e; } var *= (1.f / 128.f);
        const float rs = rsqrtf(var + LN_EPS);
        for (int d = 0; d < 128; ++d) v[tid][d] = (v[tid][d] - mu) * rs * gv[h * HD + d];
    }
    __syncthreads();
    const int d = tid & 127, th = tid >> 7;
    for (int t = th * 64; t < th * 64 + 64; ++t) {
        const float* w = ws + ((size_t)h * CH + t) * CH; float acc = 0.f;
        for (int s = 0; s <= t; ++s) acc += w[s] * v[s][d];
        acc += bs[h * CH + t];
        const size_t r = (size_t)(row0 + t);
        y[r * D + h * HD + d] = z[r * NIN + h * HD + d] * acc;
    }
}

__global__ void __launch_bounds__(256) k_pool(const float* z, const float* wp, const float* sp, float* y) {
    __shared__ float pl[64][129];
    const int tb = blockIdx.x, g = blockIdx.y, row0 = tb * 64, tid = threadIdx.x;
    const int wins[4] = {2, 4, 8, 16}; const int w = wins[g];
    for (int i = tid; i < 64 * 128; i += 256) {
        const int tt = i >> 7, c = i & 127, row = row0 + tt, t = row % S;
        float sum = 0.f; const int lo = (t - w + 1) < 0 ? 0 : (t - w + 1);
        for (int s = lo; s <= t; ++s) sum += z[(size_t)(row - t + s) * NIN + 2 * GW + g * 128 + c];
        const float cnt = (float)((t + 1) < w ? (t + 1) : w);
        pl[tt][c] = sum / cnt - z[(size_t)row * NIN + 2 * GW + g * 128 + c];
    }
    __syncthreads();
    const int d = tid & 127, th = tid >> 7;
    for (int tt = th * 32; tt < th * 32 + 32; ++tt) {
        float acc = 0.f; for (int c = 0; c < 128; ++c) acc += pl[tt][c] * wp[((size_t)g * 128 + c) * 128 + d];
        y[(size_t)(row0 + tt) * D + GW + g * 128 + d] = acc * sp[g * 128 + d];
    }
}

__global__ void __launch_bounds__(512) k_conv(const float* z, const float* wdw, const float* bdw, const float* lg, const float* lb, float* y) {
    __shared__ float red[8];
    const int row = blockIdx.x, t = row % S, c = threadIdx.x;
    float acc = 0.f;
    for (int j = 0; j < CK; ++j) { const int ts = t + j - (CK - 1); if (ts < 0) continue; const size_t r = (size_t)(row - t + ts);
        const float cv = z[r * NIN + 2 * GW + PW + c], cg = z[r * NIN + 2 * GW + PW + CW + c]; acc += wdw[j * CW + c] * (cv * sigmoidf(cg)); }
    acc += bdw[c];
    float s = acc; for (int o = 32; o > 0; o >>= 1) s += __shfl_xor(s, o);
    if ((c & 63) == 0) red[c >> 6] = s; __syncthreads();
    float mu = 0.f; for (int i = 0; i < 8; ++i) mu += red[i]; mu *= (1.f / 512.f);
    __syncthreads();
    const float e = acc - mu; float q = e * e; for (int o = 32; o > 0; o >>= 1) q += __shfl_xor(q, o);
    if ((c & 63) == 0) red[c >> 6] = q; __syncthreads();
    float var = 0.f; for (int i = 0; i < 8; ++i) var += red[i]; var *= (1.f / 512.f);
    const float ln = e * rsqrtf(var + LN_EPS) * lg[c] + lb[c];
    y[(size_t)row * D + GW + PW + c] = ln * sigmoidf(ln);
}

__global__ void __launch_bounds__(256) k_attn(const float* q, const float* kk, const float* vv, float* o) {
    __shared__ float qs[512], p[256], red[8];
    const int row = blockIdx.x, h = blockIdx.y, b = row / S, j = threadIdx.x;
    qs[j] = q[(size_t)row * D + h * XD + j]; qs[j + 256] = q[(size_t)row * D + h * XD + 256 + j];
    __syncthreads();
    const float* kr = kk + (size_t)(b * MEM + j) * D + h * XD; float sc = 0.f;
    for (int d = 0; d < XD; ++d) sc += qs[d] * kr[d];
    sc *= 0.044194173824159216f;
    float mx = sc; for (int o2 = 32; o2 > 0; o2 >>= 1) mx = fmaxf(mx, __shfl_xor(mx, o2));
    if ((j & 63) == 0) red[j >> 6] = mx; __syncthreads();
    mx = fmaxf(fmaxf(red[0], red[1]), fmaxf(red[2], red[3])); __syncthreads();
    const float e = expf(sc - mx); float sm = e; for (int o2 = 32; o2 > 0; o2 >>= 1) sm += __shfl_xor(sm, o2);
    if ((j & 63) == 0) red[j >> 6] = sm; __syncthreads();
    sm = red[0] + red[1] + red[2] + red[3];
    p[j] = e / sm; __syncthreads();
    for (int d = j; d < XD; d += 256) { float acc = 0.f; for (int m = 0; m < MEM; ++m) acc += p[m] * vv[(size_t)(b * MEM + m) * D + h * XD + d]; o[(size_t)row * D + h * XD + d] = acc; }
}
}
__global__ void k_bf2f(const unsigned short* in, float* out, size_t n) { size_t i = (size_t)blockIdx.x * 256 + threadIdx.x; if (i < n) out[i] = __builtin_bit_cast(float, (unsigned)in[i] << 16); }
__global__ void k_bf2f_t(const unsigned short* in, float* out, int R, int C) {
    size_t i = (size_t)blockIdx.x * 256 + threadIdx.x; if (i < (size_t)R * C) { const int r = i / C, c = i % C; out[(size_t)c * R + r] = __builtin_bit_cast(float, (unsigned)in[i] << 16); } }
__global__ void k_bf2f_cols(const unsigned short* in, float* out, int R, int C, int c0, int c1) {
    size_t i = (size_t)blockIdx.x * 256 + threadIdx.x; const int w = c1 - c0; if (i < (size_t)R * w) { const int r = i / w, c = c0 + i % w; out[(size_t)r * C + c] = __builtin_bit_cast(float, (unsigned)in[(size_t)r * C + c] << 16); } }
#ifndef DBG_MODE
#define DBG_MODE 7
#endif
static void naive_from(void* const* d_in, void* d_out, void* d_ws, hipStream_t stream, int from) {
    using nv::k_rmsnorm; using nv::k_gemm; using nv::k_gmlp; using nv::k_pool; using nv::k_conv; using nv::k_attn;
    const float* mem = (const float*)d_in[1];
    const float *n_mix_pre = (const float*)d_in[2], *n_mix_post = (const float*)d_in[3], *w_in = (const float*)d_in[4], *w_out = (const float*)d_in[5], *g_v = (const float*)d_in[6],
                *w_sp = (const float*)d_in[7], *b_sp = (const float*)d_in[8], *w_pool = (const float*)d_in[9], *s_pool = (const float*)d_in[10], *w_dw = (const float*)d_in[11], *b_dw = (const float*)d_in[12],
                *cln_g = (const float*)d_in[13], *cln_b = (const float*)d_in[14], *n_xa_pre = (const float*)d_in[15], *n_mem = (const float*)d_in[16], *n_xa_post = (const float*)d_in[17],
                *w_q = (const float*)d_in[18], *w_k = (const float*)d_in[19], *w_v = (const float*)d_in[20], *w_o = (const float*)d_in[21], *n_ffn_pre = (const float*)d_in[22], *n_ffn_post = (const float*)d_in[23],
                *w_up = (const float*)d_in[24], *w_down = (const float*)d_in[25];
    float* xr = (float*)d_out;
    const size_t MD = (size_t)nv::M * nv::D;
    float* ws = (float*)d_ws;
    float* hn = ws; float* hb = hn + MD; float* mn = hb + MD; float* kk = mn + (size_t)nv::MM * nv::D; float* vv = kk + (size_t)nv::MM * nv::D; float* big = vv + (size_t)nv::MM * nv::D;
    float* z = big; float* y = big + (size_t)nv::M * nv::NIN; float* q = big; float* o = big + MD; float* up = big;
    const unsigned char* mws = (const unsigned char*)d_ws;
    if (DBG_MODE == 1 || DBG_MODE == 2 || (DBG_MODE >= 5 && DBG_MODE <= 7)) {
        const int l = 0;
        if (DBG_MODE != 2) {
            k_bf2f<<<(unsigned)(((size_t)nv::M * nv::NIN + 255) / 256), 256, 0, stream>>>((const unsigned short*)(mws + WS_BIG + BO_Z), z, (size_t)nv::M * nv::NIN);
            k_gmlp<<<dim3(nv::M / nv::CH, nv::GH), 256, 0, stream>>>(z, g_v + l * nv::GH * nv::HD, w_sp + (size_t)l * nv::GH * nv::CH * nv::CH, b_sp + l * nv::GH * nv::CH, y);
            k_pool<<<dim3(nv::M / 64, nv::PG), 256, 0, stream>>>(z, w_pool + (size_t)l * nv::PG * 128 * 128, s_pool + l * nv::PW, y);
            k_conv<<<nv::M, 512, 0, stream>>>(z, w_dw + (size_t)l * nv::CK * nv::CW, b_dw + l * nv::CW, cln_g + l * nv::CW, cln_b + l * nv::CW, y);
            if (DBG_MODE >= 5) { const int c0 = DBG_MODE == 5 ? 0 : (DBG_MODE == 6 ? 1024 : 1536), c1 = DBG_MODE == 5 ? 1024 : (DBG_MODE == 6 ? 1536 : 2048);
                k_bf2f_cols<<<(unsigned)(((size_t)nv::M * (c1 - c0) + 255) / 256), 256, 0, stream>>>((const unsigned short*)(mws + WS_BIG + BO_Y), y, nv::M, nv::D, c0, c1); }
        } else {
            k_bf2f<<<(unsigned)((MD + 255) / 256), 256, 0, stream>>>((const unsigned short*)(mws + WS_BIG + BO_Y), y, MD);
        }
        k_gemm<0><<<dim3(nv::D / 64, nv::M / 64), 256, 0, stream>>>(y, w_out + (size_t)l * nv::D * nv::D, hb, nv::M, nv::D, nv::D, 0);
        k_rmsnorm<1><<<nv::M, 256, 0, stream>>>(hb, n_mix_post + l * nv::D, xr, nv::D);
    }
    if (DBG_MODE == 3 || DBG_MODE == 4) {
        const int l = 0;
        if (DBG_MODE == 3) {
            k_bf2f<<<(unsigned)((MD + 255) / 256), 256, 0, stream>>>((const unsigned short*)(mws + WS_BIG + BO_Q), q, MD);
            k_bf2f<<<(unsigned)(((size_t)nv::MM * nv::D + 255) / 256), 256, 0, stream>>>((const unsigned short*)(mws + WS_KB), kk, (size_t)nv::MM * nv::D);
            k_bf2f_t<<<(unsigned)(((size_t)nv::MM * nv::D + 255) / 256), 256, 0, stream>>>((const unsigned short*)(mws + WS_VT), vv, nv::D, nv::MM);
            k_attn<<<dim3(nv::M, nv::XH), 256, 0, stream>>>(q, kk, vv, o);
        } else {
            k_bf2f<<<(unsigned)((MD + 255) / 256), 256, 0, stream>>>((const unsigned short*)(mws + WS_BIG + BO_O), o, MD);
        }
        k_gemm<0><<<dim3(nv::D / 64, nv::M / 64), 256, 0, stream>>>(o, w_o + (size_t)l * nv::D * nv::D, hb, nv::M, nv::D, nv::D, 0);
        k_rmsnorm<1><<<nv::M, 256, 0, stream>>>(hb, n_xa_post + l * nv::D, xr, nv::D);
    }
    for (int sl = from; sl < 6; ++sl) {
        const int l = sl / 3, k = sl % 3;
        if (k == 0) {
            k_rmsnorm<0><<<nv::M, 256, 0, stream>>>(xr, n_mix_pre + l * nv::D, hn, nv::D);
            k_gemm<1><<<dim3(nv::NIN / 64, nv::M / 64), 256, 0, stream>>>(hn, w_in + (size_t)l * nv::D * nv::NIN, z, nv::M, nv::NIN, nv::D, 2 * nv::GW);
            k_gmlp<<<dim3(nv::M / nv::CH, nv::GH), 256, 0, stream>>>(z, g_v + l * nv::GH * nv::HD, w_sp + (size_t)l * nv::GH * nv::CH * nv::CH, b_sp + l * nv::GH * nv::CH, y);
            k_pool<<<dim3(nv::M / 64, nv::PG), 256, 0, stream>>>(z, w_pool + (size_t)l * nv::PG * 128 * 128, s_pool + l * nv::PW, y);
            k_conv<<<nv::M, 512, 0, stream>>>(z, w_dw + (size_t)l * nv::CK * nv::CW, b_dw + l * nv::CW, cln_g + l * nv::CW, cln_b + l * nv::CW, y);
            k_gemm<0><<<dim3(nv::D / 64, nv::M / 64), 256, 0, stream>>>(y, w_out + (size_t)l * nv::D * nv::D, hb, nv::M, nv::D, nv::D, 0);
            k_rmsnorm<1><<<nv::M, 256, 0, stream>>>(hb, n_mix_post + l * nv::D, xr, nv::D);
        } else if (k == 1) {
            k_rmsnorm<0><<<nv::M, 256, 0, stream>>>(xr, n_xa_pre + l * nv::D, hn, nv::D);
            k_rmsnorm<0><<<nv::MM, 256, 0, stream>>>(mem, n_mem + l * nv::D, mn, nv::D);
            k_gemm<0><<<dim3(nv::D / 64, nv::M / 64), 256, 0, stream>>>(hn, w_q + (size_t)l * nv::D * nv::D, q, nv::M, nv::D, nv::D, 0);
            k_gemm<0><<<dim3(nv::D / 64, nv::MM / 64), 256, 0, stream>>>(mn, w_k + (size_t)l * nv::D * nv::D, kk, nv::MM, nv::D, nv::D, 0);
            k_gemm<0><<<dim3(nv::D / 64, nv::MM / 64), 256, 0, stream>>>(mn, w_v + (size_t)l * nv::D * nv::D, vv, nv::MM, nv::D, nv::D, 0);
            k_attn<<<dim3(nv::M, nv::XH), 256, 0, stream>>>(q, kk, vv, o);
            k_gemm<0><<<dim3(nv::D / 64, nv::M / 64), 256, 0, stream>>>(o, w_o + (size_t)l * nv::D * nv::D, hb, nv::M, nv::D, nv::D, 0);
            k_rmsnorm<1><<<nv::M, 256, 0, stream>>>(hb, n_xa_post + l * nv::D, xr, nv::D);
        } else {
            k_rmsnorm<0><<<nv::M, 256, 0, stream>>>(xr, n_ffn_pre + l * nv::D, hn, nv::D);
            k_gemm<2><<<dim3(nv::FF / 64, nv::M / 64), 256, 0, stream>>>(hn, w_up + (size_t)l * nv::D * nv::FF, up, nv::M, nv::FF, nv::D, 0);
            k_gemm<0><<<dim3(nv::D / 64, nv::M / 64), 256, 0, stream>>>(up, w_down + (size_t)l * nv::FF * nv::D, hb, nv::M, nv::D, nv::FF, 0);
            k_rmsnorm<1><<<nv::M, 256, 0, stream>>>(hb, n_ffn_post + l * nv::D, xr, nv::D);
        }
    }
}
#endif

extern "C" void kernel_launch(void* const* d_in, const int* in_sizes, int n_in, void* d_out, int out_size, void* d_ws, size_t ws_size, hipStream_t stream) {
    static int grid = 0;
    if (grid == 0) {
        if (n_in != 26 || in_sizes[0] != M * D || out_size != M * D || ws_size < WS_END) { fprintf(stderr, "kernel_launch: unexpected shapes (n_in %d, in0 %d, out %d, ws %zu < %zu); nothing launched\n", n_in, n_in > 0 ? in_sizes[0] : -1, out_size, ws_size, (size_t)WS_END); grid = -1; return; }
        int dev = 0, cus = 0, per_cu = 0;
        if (hipGetDevice(&dev) != hipSuccess || hipDeviceGetAttribute(&cus, hipDeviceAttributeMultiprocessorCount, dev) != hipSuccess) { grid = -1; return; }
        if (hipFuncSetAttribute((const void*)mega_fwd, hipFuncAttributeMaxDynamicSharedMemorySize, LDS_BYTES) != hipSuccess) { fprintf(stderr, "kernel_launch: hipFuncSetAttribute failed\n"); grid = -1; return; }
        if (hipOccupancyMaxActiveBlocksPerMultiprocessor(&per_cu, (const void*)mega_fwd, NWAVES * 64, LDS_BYTES) != hipSuccess || per_cu < 1) { fprintf(stderr, "kernel_launch: occupancy query says %d blocks per CU\n", per_cu); per_cu = 1; }
        (void)hipGetLastError();
        grid = cus * 1;
    }
    if (grid < 0) return;
    if (hipMemsetAsync((char*)d_ws + WS_CTL, 0, CTL_ZERO_BYTES, stream) != hipSuccess) { fprintf(stderr, "kernel_launch: memset failed\n"); return; }
    Args a{};
    for (int i = 0; i < 26; ++i) a.in[i] = (const float*)d_in[i];
    a.out = (float*)d_out; a.ws = (unsigned char*)d_ws;
    a.rep = PROBE_REP;
    { const int stops[7] = {1, 5, 8, 11, 15, 18, 1000}; a.stop = stops[DBG_CUT]; }
#if DBG_CUT < 6
    if (DBG_MODE == 1) a.stop = 2; if (DBG_MODE == 2 || DBG_MODE >= 5) a.stop = 3; if (DBG_MODE == 3) a.stop = 6; if (DBG_MODE == 4) a.stop = 8;
#endif
    void* kargs[] = {&a};
    hipError_t e = hipLaunchCooperativeKernel((const void*)mega_fwd, dim3(grid), dim3(NWAVES * 64), kargs, LDS_BYTES, stream);
    if (e != hipSuccess) fprintf(stderr, "kernel_launch: cooperative launch failed: %s (grid %d)\n", hipGetErrorString(e), grid);
#if DBG_CUT < 6
    naive_from(d_in, d_out, d_ws, stream, DBG_CUT);
#endif
}
```

```cpp
#include <hip/hip_runtime.h>
#include <cstdio>
#include <cstdint>

#define LAS __attribute__((address_space(3)))
#define GAS __attribute__((address_space(1)))
typedef unsigned short bf16_t;
typedef short bf16x8 __attribute__((ext_vector_type(8)));
typedef float f32x4 __attribute__((ext_vector_type(4)));
typedef float f32x2 __attribute__((ext_vector_type(2)));
typedef unsigned u32x4 __attribute__((ext_vector_type(4)));
typedef unsigned u32x2 __attribute__((ext_vector_type(2)));

constexpr int D = 2048, NB = 4, SEQ = 2048, NL = 2, MEM = 256, GW = 1024, PW = 512, CW = 512, NIN = 3584, GH = 8, HD = 128, CH = 128, PG = 4, CK = 31, XH = 4, XD = 512, FF = 8192;
constexpr int M = NB * SEQ, MM = NB * MEM;
constexpr float RMS_EPS = 1e-6f, LN_EPS = 1e-5f;

constexpr size_t MiB = 1u << 20;
constexpr size_t WS_CTL = 0, CTL_ZERO_BYTES = 32 * 1024;
constexpr size_t WS_WPT = 1 * MiB, WS_WSM = 1 * MiB + 256 * 1024;
constexpr size_t WS_W = 2 * MiB, W_LAYER = 118 * MiB;
constexpr size_t WO_IN = 0, WO_OUT = 14 * MiB, WO_Q = 22 * MiB, WO_KV = 30 * MiB, WO_O = 46 * MiB, WO_UP = 54 * MiB, WO_DN = 86 * MiB;
constexpr size_t WS_MN = 238 * MiB;
constexpr size_t WS_KB = 246 * MiB, WS_VB = 250 * MiB, WS_VT = WS_VB;
constexpr size_t WS_XN = 254 * MiB;
constexpr size_t WS_HB = 286 * MiB;
constexpr size_t WS_BIG = 350 * MiB;
constexpr size_t BO_Z = 0, BO_Y = 56 * MiB, BO_Q = 0, BO_P = 32 * MiB, BO_O = 64 * MiB, BO_UP = 0;
constexpr size_t BO_GT = 0, BO_UT = 16 * MiB;
constexpr size_t WS_XH = 478 * MiB;
constexpr size_t WS_END = 510 * MiB;
constexpr int CW_BAR = 4096;

constexpr int RING_BYTES = 131072, LDSCTL_OFF = RING_BYTES, MISC_OFF = LDSCTL_OFF + 320, LDS_BYTES = 147456;
constexpr int NWAVES = 8;

#define LDS_WAIT() asm volatile("s_waitcnt lgkmcnt(0)" ::: "memory")
#define VM_WAIT() asm volatile("s_waitcnt vmcnt(0)" ::: "memory")
#define RLX_AGENT __ATOMIC_RELAXED, __HIP_MEMORY_SCOPE_AGENT

__device__ __forceinline__ unsigned cvt_pk_bf16(float lo, float hi) { unsigned r; asm volatile("v_cvt_pk_bf16_f32 %0, %1, %2" : "=v"(r) : "v"(lo), "v"(hi)); return r; }
__device__ __forceinline__ float bf_lo(unsigned w) { return __builtin_bit_cast(float, w << 16); }
__device__ __forceinline__ float bf_hi(unsigned w) { return __builtin_bit_cast(float, w & 0xffff0000u); }
typedef _Float16 f16x2 __attribute__((ext_vector_type(2)));
__device__ __forceinline__ unsigned pk_f16(float a, float b) { f16x2 v; v[0] = (_Float16)a; v[1] = (_Float16)b; return __builtin_bit_cast(unsigned, v); }
__device__ __forceinline__ f32x2 unpk_f16(unsigned w) { const f16x2 v = __builtin_bit_cast(f16x2, w); const _Float16 a = v[0], b = v[1]; return (f32x2){(float)a, (float)b}; }
__device__ __forceinline__ float fast_sigmoid(float x) { return __builtin_amdgcn_rcpf(1.f + __builtin_amdgcn_exp2f(-1.44269504089f * x)); }
__device__ __forceinline__ float gelu_tanh(float x) { const float u = 0.7978845608028654f * (x + 0.044715f * x * x * x); return x * fast_sigmoid(2.f * u); }
__device__ __forceinline__ int opaque_s(int v) { asm volatile("" : "+s"(v)); return v; }
__device__ __forceinline__ int fresh_tid() { int t = threadIdx.x; asm volatile("" : "+v"(t)); return t; }
template <int CTRL> __device__ __forceinline__ float dppf(float v) { return __builtin_bit_cast(float, __builtin_amdgcn_update_dpp(0, __builtin_bit_cast(int, v), CTRL, 0xf, 0xf, true)); }
__device__ __forceinline__ float lx1(float v) { return dppf<0xB1>(v); }
__device__ __forceinline__ float lx2(float v) { return dppf<0x4E>(v); }
__device__ __forceinline__ float lx16(float v) { return __builtin_bit_cast(float, __builtin_amdgcn_ds_swizzle(__builtin_bit_cast(int, v), 0x401F)); }
__device__ __forceinline__ void halves32(float v, float& lo, float& hi) {
    const unsigned u = __builtin_bit_cast(unsigned, v); auto r = __builtin_amdgcn_permlane32_swap(u, u, false, false);
    const unsigned r0 = r[0], r1 = r[1];
    lo = __builtin_bit_cast(float, r0); hi = __builtin_bit_cast(float, r1); }
__device__ __forceinline__ float sum_x32(float v) { float a, b; halves32(v, a, b); return a + b; }
__device__ __forceinline__ float max_x32(float v) { float a, b; halves32(v, a, b); return fmaxf(a, b); }
__device__ __forceinline__ float wave_sum(float v) {
    v += lx1(v); v += lx2(v); v += dppf<0x141>(v)  ; v += dppf<0x140>(v)  ; v += lx16(v); return sum_x32(v);
}

#define XB_TMO      128
#define XB_XCNT(j)  (256  + 64 * (j))
#define XB_XSUB(j)  (1280 + 64 * (j))
#define XB_XGEN(j)  (2304 + 64 * (j))
#define XB_TOP      3328
#define XB_TOPGEN   3392
#define XCD_BAR_WORDS 3456
#define XB_SPIN_CAP (1u << 18)
__device__ __forceinline__ unsigned xb_ld(unsigned* p)              { return __hip_atomic_load(p, __ATOMIC_RELAXED, __HIP_MEMORY_SCOPE_AGENT); }
__device__ __forceinline__ unsigned xb_add(unsigned* p, unsigned v) { return __hip_atomic_fetch_add(p, v, __ATOMIC_RELAXED, __HIP_MEMORY_SCOPE_AGENT); }
__device__ __forceinline__ unsigned xb_xcc_id() { return (unsigned)__builtin_amdgcn_s_getreg((3 << 11) | 20) & 0xFu; }
#define XB_SPIN(cond, bar) do { unsigned _sp = 0; while (cond) { __builtin_amdgcn_s_sleep(1); \
    if ((++_sp & 255u) == 0u) { if (xb_ld(&(bar)[XB_TMO])) break; if (_sp > XB_SPIN_CAP) { atomicAdd(&(bar)[XB_TMO], 1u); break; } } } } while (0)
struct XcdBarrier { unsigned* bar; unsigned x; volatile LAS unsigned* st; };
__device__ __forceinline__ XcdBarrier xcd_barrier_post(unsigned* bar, volatile LAS unsigned* st) {
    XcdBarrier b; b.bar = bar; b.x = xb_xcc_id(); b.st = st;
    if (threadIdx.x == 0) (void)xb_add(&bar[XB_XCNT(b.x)], 1u);
    return b;
}
__device__ __forceinline__ void xcd_barrier_complete(unsigned* bar, unsigned x, unsigned& nloc, unsigned& nx) {
    const unsigned G = gridDim.x * gridDim.y * gridDim.z;
    unsigned sum, cnt, mine, sp = 0u;
    for (;;) {
        sum = 0u; cnt = 0u; mine = 0u;
#pragma unroll
        for (unsigned j = 0; j < 16; ++j) { const unsigned c = xb_ld(&bar[XB_XCNT(j)]); sum += c; cnt += (c > 0u) ? 1u : 0u; mine = (j == x) ? c : mine; }
        if (sum == G) break;
        __builtin_amdgcn_s_sleep(1);
        if ((++sp & 255u) == 0u) { if (xb_ld(&bar[XB_TMO])) break; if (sp > XB_SPIN_CAP) { atomicAdd(&bar[XB_TMO], 1u); break; } }
    }
    nloc = mine > 0u ? mine : 1u; nx = cnt > 0u ? cnt : 1u;
}
__device__ __forceinline__ void xcd_barrier(const XcdBarrier& b) {
    asm volatile("s_waitcnt vmcnt(0)" ::: "memory");
    __syncthreads();
    if (threadIdx.x == 0) {
        unsigned* bar = b.bar; asm volatile("" : "+s"(bar));
        __builtin_amdgcn_s_waitcnt(0);
        unsigned nloc = b.st[0], nx = b.st[1]; unsigned bx = b.x; asm volatile("" : "+s"(bx));
        if (nloc == 0u) { xcd_barrier_complete(bar, bx, nloc, nx); b.st[0] = nloc; b.st[1] = nx; }
        const unsigned old = xb_add(&bar[XB_XSUB(bx)], 1u);
        const unsigned gen = old / nloc;
        if (old + 1u == (gen + 1u) * nloc) {
            __builtin_amdgcn_fence(__ATOMIC_RELEASE, "agent");
            asm volatile("s_waitcnt vmcnt(0)" ::: "memory");
            const unsigned og = xb_add(&bar[XB_TOP], 1u);
            const unsigned tg = og / nx;
            if (og + 1u == (tg + 1u) * nx) xb_add(&bar[XB_TOPGEN], 1u);
            else XB_SPIN(xb_ld(&bar[XB_TOPGEN]) == tg, bar);
            __builtin_amdgcn_fence(__ATOMIC_ACQUIRE, "agent");
            xb_add(&bar[XB_XGEN(bx)], 1u);
            asm volatile("s_waitcnt vmcnt(0)" ::: "memory");
        } else {
            XB_SPIN(xb_ld(&bar[XB_XGEN(bx)]) == gen, bar);
            __builtin_amdgcn_fence(__ATOMIC_ACQUIRE, "agent");
            asm volatile("s_waitcnt vmcnt(0)" ::: "memory");
        }
    }
    __syncthreads();
}

namespace pg8 {
constexpr int BM = 256, BK = 64, HALF = 128, HTB = HALF * BK * 2, STAGE_BYTES = 8 * HTB, NXCD = 8, WGM = 8;
__host__ __device__ __forceinline__ int lds_byte(int r, int c) { const int st = (r >> 4) * 2 + (c >> 5), rr = r & 15, cc = c & 31, ob = rr * 64 + cc * 2; return st * 1024 + (ob ^ (((ob >> 9) & 1) << 5)); }
__host__ __device__ __forceinline__ void stage_rc(int b, int& R, int& C) { const int st = b / 1024, sb = b % 1024, swz = sb ^ (((sb >> 9) & 1) << 5); R = (st >> 1) * 16 + swz / 64; C = (st & 1) * 32 + (swz % 64) / 2; }
__host__ __device__ __forceinline__ int perm32(int rho) { const int n = rho >> 4, i = rho & 15; return 8 * (i >> 2) + 4 * n + (i & 3); }

struct Unit { const char* A; const char* B; void* O; int ldo, pm, pn, flag, nt; };

__device__ __forceinline__ void tile_order(int L, int nM, int nN, int& pm, int& pn) {
    const int nwg = nM * nN; int wgid = L; { const int q = nwg / NXCD, r = nwg % NXCD, xcd = wgid % NXCD, off = wgid / NXCD; wgid = (xcd < r ? xcd * (q + 1) : r * (q + 1) + (xcd - r) * q) + off; }
    const int nig = WGM * nN, gid = wgid / nig, fm = gid * WGM, gsz = (nM - fm) < WGM ? (nM - fm) : WGM;
    pm = fm + ((wgid % nig) % gsz); pn = (wgid % nig) / gsz;
}

struct EpiF32 {
    static constexpr bool PERM = false, AFTER_DRAIN = false;
    __device__ __forceinline__ void operator()(const f32x4 (&acc)[2][2][4][2], const Unit& u, int wr, int wc, int fr, int fq) const {
        { const int t_ = fresh_tid(); fr = t_ & 15; fq = (t_ >> 4) & 3; }
        const int row0 = u.pm * BM + wr * 64 + fr, col0 = u.pn * BM + wc * 32 + 4 * fq; float* C = (float*)u.O;
#pragma unroll
        for (int ai = 0; ai < 2; ++ai)
#pragma unroll
            for (int m = 0; m < 4; ++m) { float* rowp = C + (size_t)(row0 + ai * HALF + m * 16) * u.ldo + col0;
#pragma unroll
                for (int bj = 0; bj < 2; ++bj)
#pragma unroll
                    for (int n = 0; n < 2; ++n) *(f32x4*)(rowp + bj * HALF + n * 16) = acc[ai][bj][m][n]; }
    }
};
template <int ACT> struct EpiBf16 {
    static constexpr bool PERM = true, AFTER_DRAIN = false;
    __device__ __forceinline__ void operator()(const f32x4 (&acc)[2][2][4][2], const Unit& u, int wr, int wc, int fr, int fq) const {
        { const int t_ = fresh_tid(); fr = t_ & 15; fq = (t_ >> 4) & 3; }
        const int row0 = u.pm * BM + wr * 64 + fr, col0 = u.pn * BM + wc * 32 + 8 * fq; bf16_t* base = (bf16_t*)u.O;
        const bool act1 = (ACT == 1) && (u.flag != 0);
#pragma unroll
        for (int ai = 0; ai < 2; ++ai)
#pragma unroll
            for (int m = 0; m < 4; ++m) { bf16_t* rowp = base + (size_t)(row0 + ai * HALF + m * 16) * u.ldo + col0;
#pragma unroll
                for (int bj = 0; bj < 2; ++bj) { f32x4 v0 = acc[ai][bj][m][0], v1 = acc[ai][bj][m][1];
                    if (ACT == 1) { if (act1) {
#pragma unroll
                        for (int e = 0; e < 4; ++e) { v0[e] = gelu_tanh(v0[e]); v1[e] = gelu_tanh(v1[e]); } } }
                    if (ACT == 2) {
#pragma unroll
                        for (int e = 0; e < 4; ++e) { const float a = fmaxf(v0[e], 0.f), b = fmaxf(v1[e], 0.f); v0[e] = a * a; v1[e] = b * b; } }
                    u32x4 w; w.x = cvt_pk_bf16(v0[0], v0[1]); w.y = cvt_pk_bf16(v0[2], v0[3]); w.z = cvt_pk_bf16(v1[0], v1[1]); w.w = cvt_pk_bf16(v1[2], v1[3]);
                    *(u32x4*)(rowp + bj * HALF) = w; } }
    }
};
struct EpiSoftmax {
    static constexpr bool PERM = true, AFTER_DRAIN = true;
    float scale_log2e;
    __device__ __forceinline__ void fused(f32x4 (&acc)[2][2][4][2], const Unit& u, int wr, int wc, int fr, int fq, LAS unsigned char* lds, int wid, int lane) const {
        LAS f32x2* P = (LAS f32x2*)lds;
#pragma unroll
        for (int ai = 0; ai < 2; ++ai)
#pragma unroll
            for (int m = 0; m < 4; ++m) {
                float mx = -3.0e38f;
#pragma unroll
                for (int bj = 0; bj < 2; ++bj)
#pragma unroll
                    for (int n = 0; n < 2; ++n) { const f32x4 x = acc[ai][bj][m][n]; mx = fmaxf(mx, fmaxf(fmaxf(x[0], x[1]), fmaxf(x[2], x[3]))); }
                mx = fmaxf(mx, lx16(mx)); mx = max_x32(mx);
                float s = 0.f;
#pragma unroll
                for (int bj = 0; bj < 2; ++bj)
#pragma unroll
                    for (int n = 0; n < 2; ++n) { f32x4 x = acc[ai][bj][m][n];
#pragma unroll
                        for (int e = 0; e < 4; ++e) { x[e] = __builtin_amdgcn_exp2f((x[e] - mx) * scale_log2e); s += x[e]; }
                        acc[ai][bj][m][n] = x; }
                s += lx16(s); s = sum_x32(s);
                if (fq == 0) P[(ai * HALF + wr * 64 + m * 16 + fr) * 4 + wc] = (f32x2){mx, s};
            }
        asm volatile("s_waitcnt lgkmcnt(0)" ::: "memory"); __builtin_amdgcn_s_barrier(); asm volatile("" ::: "memory");
        const int row0 = u.pm * BM + wr * 64 + fr, col0 = u.pn * BM + wc * 32 + 8 * fq; bf16_t* base = (bf16_t*)u.O;
#pragma unroll
        for (int ai = 0; ai < 2; ++ai)
#pragma unroll
            for (int m = 0; m < 4; ++m) {
                const int r = ai * HALF + wr * 64 + m * 16 + fr;
                const f32x2 a = P[r * 4 + 0], b = P[r * 4 + 1], c = P[r * 4 + 2], d = P[r * 4 + 3];
                const float mt = fmaxf(fmaxf(a.x, b.x), fmaxf(c.x, d.x));
                const float ea = __builtin_amdgcn_exp2f((a.x - mt) * scale_log2e), eb = __builtin_amdgcn_exp2f((b.x - mt) * scale_log2e), ec = __builtin_amdgcn_exp2f((c.x - mt) * scale_log2e), ed = __builtin_amdgcn_exp2f((d.x - mt) * scale_log2e);
                const float tot = a.y * ea + b.y * eb + c.y * ec + d.y * ed;
                const float mine = (wc == 0 ? ea : wc == 1 ? eb : wc == 2 ? ec : ed) / tot;
                bf16_t* rowp = base + (size_t)(row0 + ai * HALF + m * 16) * u.ldo + col0;
#pragma unroll
                for (int bj = 0; bj < 2; ++bj) { const f32x4 v0 = acc[ai][bj][m][0] * mine, v1 = acc[ai][bj][m][1] * mine;
                    u32x4 w; w.x = cvt_pk_bf16(v0[0], v0[1]); w.y = cvt_pk_bf16(v0[2], v0[3]); w.z = cvt_pk_bf16(v1[0], v1[1]); w.w = cvt_pk_bf16(v1[2], v1[3]);
                    *(u32x4*)(rowp + bj * HALF) = w; }
            }
    }
};

template <class Epi, class Sched>
__device__ __forceinline__ void gemm_phase(LAS unsigned char* lds, const int lda, const int ldb, const Sched& S, const Epi& E) {
    const int tid = fresh_tid(), wid = __builtin_amdgcn_readfirstlane(tid >> 6), lane = tid & 63, wr = wid >> 2, wc = wid & 3, fr = lane & 15, fq = lane >> 4;
    unsigned voffA[2], voffB[2];
#pragma unroll
    for (int i = 0; i < 2; ++i) { int R, C; stage_rc(tid * 16 + i * 8192, R, C); const int Rb = Epi::PERM ? ((R & ~31) + perm32(R & 31)) : R;
        voffA[i] = (unsigned)(R * lda + C) * 2u; voffB[i] = (unsigned)(Rb * ldb + C) * 2u; }
    const size_t kstep = (size_t)(BK * 2);
    const size_t hstepA = (size_t)HALF * lda * 2, hstepB = (size_t)HALF * ldb * 2;
    const unsigned ldsw = (unsigned)wid * 1024u;
    const int aoff = lds_byte(wr * 64 + fr, fq * 8), boff = lds_byte(wc * 32 + fr, fq * 8);
#define PG8_SA(b, h) (((b) * 2 + (h)) * HTB)
#define PG8_SB(b, h) ((4 + (b) * 2 + (h)) * HTB)
#define PG8_STAGE(bufoff, gbase, voff) do { _Pragma("unroll") for (int _i = 0; _i < 2; ++_i) \
        __builtin_amdgcn_global_load_lds((const unsigned*)((const char*)(gbase) + (voff)[_i]), (LAS unsigned*)(lds + (bufoff) + ldsw + _i * 8192), 16, 0, 0); } while (0)
#define PG8_LDA(dst, b, h) do { _Pragma("unroll") for (int m = 0; m < 4; ++m) _Pragma("unroll") for (int k = 0; k < 2; ++k) dst[m][k] = *(const LAS bf16x8*)(lds + PG8_SA(b, h) + aoff + m * 2048 + k * 1024); } while (0)
#define PG8_LDB(dst, b, h) do { _Pragma("unroll") for (int n = 0; n < 2; ++n) _Pragma("unroll") for (int k = 0; k < 2; ++k) dst[n][k] = *(const LAS bf16x8*)(lds + PG8_SB(b, h) + boff + n * 2048 + k * 1024); } while (0)
#define PG8_MMA(ai, bj, At, Bt) do { __builtin_amdgcn_s_setprio(1); _Pragma("unroll") for (int m = 0; m < 4; ++m) _Pragma("unroll") for (int n = 0; n < 2; ++n) _Pragma("unroll") for (int k = 0; k < 2; ++k) \
        acc[ai][bj][m][n] = __builtin_amdgcn_mfma_f32_16x16x32_bf16(Bt[n][k], At[m][k], acc[ai][bj][m][n], 0, 0, 0); __builtin_amdgcn_s_setprio(0); } while (0)
#define PG8_WAIT_V(n) asm volatile("s_waitcnt vmcnt(" #n ")" ::: "memory")
#define PG8_WAIT_L(n) asm volatile("s_waitcnt lgkmcnt(" #n ")" ::: "memory")
#define PG8_BAR __builtin_amdgcn_s_barrier()
#define PG8_SCHED __builtin_amdgcn_sched_barrier(0)
    Unit cur, nxt; int ui = 0;
    if (!S.next(0, cur)) return;
    f32x4 acc[2][2][4][2];
#pragma unroll
    for (int a = 0; a < 2; ++a)
#pragma unroll
        for (int b = 0; b < 2; ++b)
#pragma unroll
            for (int m = 0; m < 4; ++m)
#pragma unroll
                for (int n = 0; n < 2; ++n) acc[a][b][m][n] = (f32x4){0.f, 0.f, 0.f, 0.f};
    bf16x8 At[4][2], B0[2][2], B1[2][2];
    const char* cA = cur.A; const char* cB = cur.B;
    PG8_STAGE(PG8_SB(0, 0), cB, voffB); PG8_STAGE(PG8_SB(0, 1), cB + hstepB, voffB); PG8_STAGE(PG8_SA(0, 0), cA, voffA); PG8_STAGE(PG8_SA(0, 1), cA + hstepA, voffA);
    if (wr == 1) PG8_BAR;
    PG8_WAIT_V(2); PG8_BAR;
    PG8_STAGE(PG8_SB(1, 0), cB + kstep, voffB); PG8_STAGE(PG8_SA(1, 0), cA + kstep, voffA); PG8_STAGE(PG8_SB(1, 1), cB + hstepB + kstep, voffB);
    PG8_WAIT_V(6); PG8_BAR;
    for (;;) {
        const bool has_next = S.next(ui + 1, nxt);
        const char* nA = has_next ? nxt.A : cA; const char* nB = has_next ? nxt.B : cB;
        const int nt = cur.nt;
        for (int t = 0; t < nt; t += 2) {
            const bool last = (t == nt - 2);
            const char* a1 = cA + (size_t)(t + 1) * kstep;
            const char* a2 = last ? nA : cA + (size_t)(t + 2) * kstep; const char* b2 = last ? nB : cB + (size_t)(t + 2) * kstep;
            const char* a3 = a2 + kstep; const char* b3 = b2 + kstep;
            PG8_LDB(B0, 0, 0); PG8_LDB(B1, 0, 1); PG8_SCHED; PG8_LDA(At, 0, 0); PG8_STAGE(PG8_SA(1, 1), a1 + hstepA, voffA);
            PG8_WAIT_V(8); PG8_WAIT_L(0); PG8_BAR; PG8_MMA(0, 0, At, B0); PG8_MMA(0, 1, At, B1); PG8_BAR; PG8_SCHED;
            PG8_LDA(At, 0, 1); PG8_STAGE(PG8_SB(0, 0), b2, voffB); PG8_STAGE(PG8_SB(0, 1), b2 + hstepB, voffB); PG8_STAGE(PG8_SA(0, 0), a2, voffA);
            PG8_WAIT_V(8); PG8_WAIT_L(0); PG8_BAR; PG8_MMA(1, 0, At, B0); PG8_MMA(1, 1, At, B1); PG8_BAR; PG8_SCHED;
            PG8_LDB(B0, 1, 0); PG8_LDB(B1, 1, 1); PG8_SCHED; PG8_LDA(At, 1, 0); PG8_STAGE(PG8_SA(0, 1), a2 + hstepA, voffA);
            PG8_WAIT_V(8); PG8_WAIT_L(0); PG8_BAR; PG8_MMA(0, 0, At, B0); PG8_MMA(0, 1, At, B1); PG8_BAR; PG8_SCHED;
            PG8_LDA(At, 1, 1); PG8_STAGE(PG8_SB(1, 0), b3, voffB); PG8_STAGE(PG8_SB(1, 1), b3 + hstepB, voffB); PG8_STAGE(PG8_SA(1, 0), a3, voffA);
            PG8_WAIT_V(8); PG8_WAIT_L(0); PG8_BAR; PG8_MMA(1, 0, At, B0); PG8_MMA(1, 1, At, B1); PG8_BAR; PG8_SCHED;
        }
        if (wr == 0) PG8_BAR;
        if constexpr (!Epi::AFTER_DRAIN) { E(acc, cur, wr, wc, fr, fq); }
        if (!has_next) break;
#pragma unroll
        for (int a = 0; a < 2; ++a)
#pragma unroll
            for (int b = 0; b < 2; ++b)
#pragma unroll
                for (int m = 0; m < 4; ++m)
#pragma unroll
                    for (int n = 0; n < 2; ++n) acc[a][b][m][n] = (f32x4){0.f, 0.f, 0.f, 0.f};
        cur = nxt; cA = nA; cB = nB; ++ui;
        if (wr == 1) PG8_BAR;
    }
    PG8_WAIT_V(0);
    PG8_BAR;
    if constexpr (Epi::AFTER_DRAIN) { E.fused(acc, cur, wr, wc, fr, fq, lds, wid, lane); }
#undef PG8_SA
#undef PG8_SB
#undef PG8_STAGE
#undef PG8_LDA
#undef PG8_LDB
#undef PG8_MMA
#undef PG8_WAIT_V
#undef PG8_WAIT_L
#undef PG8_BAR
#undef PG8_SCHED
}
}

template <int LDA, int LDB, int LDO, int NM, int NN, int KD> struct SchedPlain {
    const char* A; const char* B; void* O; int G, c;
    __device__ __forceinline__ bool next(int i, pg8::Unit& u) const {
        const int L = i * G + c; if (L >= NM * NN) return false;
        int pm, pn; pg8::tile_order(L, NM, NN, pm, pn);
        u.A = A + (size_t)pm * 256 * LDA * 2; u.B = B + (size_t)pn * 256 * LDB * 2; u.O = O; u.ldo = LDO; u.pm = pm; u.pn = pn; u.flag = 0; u.nt = KD / 64; return true;
    }
};
struct SchedIn {
    const char* ws; const char* wl; const char* mn; int G, c;
    __device__ __forceinline__ bool next(int i, pg8::Unit& u) const {
        const int L = i * G + c; if (L >= 512) return false;
        int pm, pn; pg8::tile_order(L < 448 ? L : 0, 32, 14, pm, pn);
        const int Lk = L - 448, Lv = L - 480; const bool isz = L < 448, isk = L < 480;
        const int pmk = Lk & 3, pnk = Lk >> 2, pmv = Lv & 3, pnv = Lv >> 2;
        pm = isz ? pm : (isk ? pmk : pmv); pn = isz ? pn : (isk ? pnk : pnv);
        const char* a0 = isz ? ws + WS_XN : mn;
        const char* b0 = isz ? wl + WO_IN : (isk ? wl + WO_KV : wl + WO_KV + (size_t)D * D * 2);
        u.A = a0 + (size_t)pm * 256 * D * 2; u.B = b0 + (size_t)pn * 256 * D * 2;
        u.O = (void*)(isz ? ws + WS_BIG + BO_Z : (isk ? ws + WS_KB : ws + WS_VB)); u.ldo = isz ? NIN : D;
        u.pm = pm; u.pn = pn; u.flag = isz && pn < 8; u.nt = D / 64; return true;
    }
};
struct SchedGU {
    const char* ws; const char* wl; int G, c;
    __device__ __forceinline__ bool next(int i, pg8::Unit& u) const {
        const int L = i * G + c;
        if (L < 256) { int pm, pn; pg8::tile_order(L, M / 256, D / 256, pm, pn);
            u.A = ws + WS_BIG + BO_Y + (size_t)pm * 256 * D * 2; u.B = wl + WO_OUT + (size_t)pn * 256 * D * 2; u.O = (void*)(ws + WS_HB); u.ldo = D; u.pm = pm; u.pn = pn; u.flag = 0; u.nt = D / 64; return true; }
        const int L2 = L - 256; if (L2 >= 256) return false;
        const bool isg = L2 < 128; const int j = L2 & 127, bh = j >> 3, t = j & 7, b = bh >> 2, h = bh & 3;
        const char* kv = ws + (isg ? WS_KB : WS_VB) + ((size_t)(b * MEM) * D + h * XD) * 2;
        const char* w = wl + (isg ? WO_Q : WO_O) + ((size_t)(t * 256) * D + h * XD) * 2;
        u.A = isg ? kv : w; u.B = isg ? w : kv;
        u.O = (void*)(isg ? ws + WS_BIG + BO_GT : ws + WS_BIG + BO_UT + (size_t)b * D * (XH * MEM) * 2);
        u.ldo = isg ? D : XH * MEM; u.pm = isg ? bh : t; u.pn = isg ? t : h; u.flag = 0; u.nt = XD / 64; return true;
    }
};
struct SchedS {
    const char* XN; const char* GT; void* P; int G, c;
    __device__ __forceinline__ bool next(int i, pg8::Unit& u) const {
        const int L = i * G + c; if (L >= 128) return false;
        const int b = L >> 5, h = (L >> 3) & 3, rp = L & 7;
        u.A = XN + (size_t)(b * SEQ + rp * 256) * D * 2; u.B = GT + (size_t)((b * 4 + h) * 256) * D * 2; u.O = P; u.ldo = XH * MEM; u.pm = b * 8 + rp; u.pn = h; u.flag = 0; u.nt = D / 64; return true;
    }
};
struct SchedO {
    const char* P; const char* UT; void* HB; int G, c;
    __device__ __forceinline__ bool next(int i, pg8::Unit& u) const {
        const int L = i * G + c; if (L >= 256) return false;
        int pm, pn; pg8::tile_order(L, 32, 8, pm, pn); const int b = pm >> 3;
        u.A = P + (size_t)pm * 256 * (XH * MEM) * 2; u.B = UT + ((size_t)b * D + pn * 256) * (XH * MEM) * 2; u.O = HB; u.ldo = D; u.pm = pm; u.pn = pn; u.flag = 0; u.nt = (XH * MEM) / 64; return true;
    }
};

struct Frame {
    LAS unsigned char* lds; int tid, lane, wave, vcu, G;
    decltype(__builtin_amdgcn_kernarg_segment_ptr()) kp; float* out; unsigned char* ws;
};
__device__ __forceinline__ const float* inp(const Frame& F, int i) { asm volatile("" : "+s"(i)); return (const float*)*(const GAS float* const*)((const char*)F.kp + 8 * i); }

__device__ __forceinline__ void refresh(Frame& F) { F.tid = fresh_tid(); F.lane = F.tid & 63; F.wave = __builtin_amdgcn_readfirstlane(F.tid >> 6); }
constexpr int T_IN = (D / 64) * (NIN / 64), T_SQ = (D / 64) * (D / 64), T_UP = (D / 64) * (FF / 64);
constexpr int T_TR = T_IN + 4 * T_SQ + 2 * T_UP;
constexpr int U_LAYER = T_TR * 2, U_ALL = NL * U_LAYER;
constexpr int U_IDLE_SHARE = 14336;
constexpr int U_IDLE_SHARE_L1 = 16384;
constexpr int U_L1_IN_S0 = 8192;
constexpr int U_EARLY = (T_IN + 4 * T_SQ) * 2;
struct TUnit { const float* src; bf16_t* dst; int N, K; };
__device__ __forceinline__ TUnit p0_unit(const Frame& F, int u) {
    const int g = u >> 3, kt = (u >> 1) & 3, hh = u & 1, l = g / (T_TR / 4); int r = g % (T_TR / 4); unsigned char* wl = F.ws + WS_W + (size_t)l * W_LAYER;
    int idx, K = D, N = D, row_off = 0; size_t wo, lsz = (size_t)D * D;
    if (r < T_IN / 4) { idx = 4; N = NIN; wo = WO_IN; lsz = (size_t)D * NIN; }
    else if ((r -= T_IN / 4) < T_SQ / 4) { idx = 5; wo = WO_OUT; }
    else if ((r -= T_SQ / 4) < T_SQ / 4) { idx = 19; wo = WO_KV; }
    else if ((r -= T_SQ / 4) < T_SQ / 4) { idx = 20; wo = WO_KV; row_off = D; }
    else if ((r -= T_SQ / 4) < T_SQ / 4) { idx = 21; wo = WO_O; }
    else if ((r -= T_SQ / 4) < T_UP / 4) { idx = 24; N = FF; wo = WO_UP; lsz = (size_t)D * FF; }
    else { r -= T_UP / 4; idx = 25; K = FF; wo = WO_DN; lsz = (size_t)D * FF; }
    const int nblk = N / 256, k0 = 64 * (r / nblk), n0 = 256 * (r % nblk) + 64 * kt + 32 * hh;
    TUnit t; t.src = inp(F, idx) + (size_t)l * lsz + (size_t)k0 * N + n0; t.dst = (bf16_t*)(wl + wo) + (size_t)(row_off + n0) * K + k0; t.N = N; t.K = K; return t;
}
__device__ __forceinline__ void p0_unit_dma(const TUnit& t, int lane, LAS unsigned char* buf) {
#pragma unroll
    for (int i = 0; i < 8; ++i)
        __builtin_amdgcn_global_load_lds((const unsigned*)(t.src + (size_t)(8 * i + (lane >> 3)) * t.N + 4 * ((lane & 7) ^ i)), (LAS unsigned*)(buf + i * 1024), 16, 0,   2);
}
__device__ __forceinline__ void p0_unit_out(const TUnit& t, int lane, const LAS float* scr) {
    const int kc = lane & 7;
#pragma unroll
    for (int j = 0; j < 4; ++j) { const int n = (lane >> 3) + 8 * j; const LAS float* s = scr + (8 * kc) * 32 + (n ^ (4 * kc));
        u32x4 o; o.x = cvt_pk_bf16(s[0 * 32], s[1 * 32]); o.y = cvt_pk_bf16(s[2 * 32], s[3 * 32]); o.z = cvt_pk_bf16(s[4 * 32], s[5 * 32]); o.w = cvt_pk_bf16(s[6 * 32], s[7 * 32]);
        *(GAS u32x4*)(t.dst + (size_t)n * t.K + 8 * kc) = o; }
}
__device__ __forceinline__ void p0_convert(Frame& F, int w0, int nw, int lo, int hi) {
    LAS unsigned char* base = F.lds + F.wave * 16384;
    int u = lo + w0; if (u >= hi) return;
    int b = 0;
    TUnit tc = p0_unit(F, u);
    p0_unit_dma(tc, F.lane, base);
    for (; u < hi; u += nw) {
        const bool more = u + nw < hi;
        TUnit tn = tc;
        if (more) { tn = p0_unit(F, u + nw); p0_unit_dma(tn, F.lane, base + (b ^ 1) * 8192); asm volatile("s_waitcnt vmcnt(8)" ::: "memory"); }
        else asm volatile("s_waitcnt vmcnt(0)" ::: "memory");
        p0_unit_out(tc, F.lane, (const LAS float*)(base + b * 8192));
        LDS_WAIT(); asm volatile("" ::: "memory");
        tc = tn; b ^= 1;
    }
}
__device__ __forceinline__ void p0_plain(Frame& F, int gw, int ngw, int l0, int l1) {
    for (int c = l0 * (D * D / 8) + gw * 64 + F.lane; c < l1 * (D * D / 8); c += ngw * 64) {
        const int l = c / (D * D / 8), r = c % (D * D / 8);
        const GAS f32x4* sp = (const GAS f32x4*)(inp(F, 18) + (size_t)l * D * D) + 2 * r; const f32x4 a = __builtin_nontemporal_load(sp), bq = __builtin_nontemporal_load(sp + 1);
        u32x4 o; o.x = cvt_pk_bf16(a.x, a.y); o.y = cvt_pk_bf16(a.z, a.w); o.z = cvt_pk_bf16(bq.x, bq.y); o.w = cvt_pk_bf16(bq.z, bq.w);
        ((GAS u32x4*)(F.ws + WS_W + (size_t)l * W_LAYER + WO_Q))[r] = o; }
}
__device__ __forceinline__ void rms_row_to_bf16(const float* xrow, const float* g, bf16_t* orow, float* cp, int lane) {
    const GAS f32x4* xr = (const GAS f32x4*)xrow + lane; f32x4 v[8]; float s = 0.f;
#pragma unroll
    for (int j = 0; j < 8; ++j) { v[j] = xr[64 * j]; s += (v[j].x * v[j].x + v[j].y * v[j].y) + (v[j].z * v[j].z + v[j].w * v[j].w); }
    const float rs = 1.f / sqrtf(wave_sum(s) * (1.f / D) + RMS_EPS);
    if (cp) { GAS f32x4* c4 = (GAS f32x4*)cp + lane;
#pragma unroll
        for (int j = 0; j < 8; ++j) c4[64 * j] = v[j]; }
    const GAS f32x4* g4 = (const GAS f32x4*)g + lane; GAS u32x2* o8 = (GAS u32x2*)orow + lane;
#pragma unroll
    for (int j = 0; j < 8; ++j) { const f32x4 gg = g4[64 * j]; u32x2 w; w.x = cvt_pk_bf16(v[j].x * rs * gg.x, v[j].y * rs * gg.y); w.y = cvt_pk_bf16(v[j].z * rs * gg.z, v[j].w * rs * gg.w); o8[64 * j] = w; }
}
__device__ __forceinline__ void p0_memnorm(Frame& F, int gw, int ngw, int l0, int l1) {
    for (int m = l0 * MM + gw; m < l1 * MM; m += ngw) { const int l = m / MM, r = m % MM;
        rms_row_to_bf16(inp(F, 1) + (size_t)r * D, inp(F, 16) + l * D, (bf16_t*)(F.ws + WS_MN) + (size_t)m * D, nullptr, F.lane); }
}
__device__ __forceinline__ void p0_prologue(Frame& F) {
    refresh(F);
    const int gw = F.vcu * NWAVES + F.wave, NGW = F.G * NWAVES;
    for (int l = 0; l < NL; ++l) p0_convert(F, gw, NGW, l * U_LAYER, (F.G == 256) ? l * U_LAYER + U_EARLY - (l == 1 ? U_L1_IN_S0 : 0) : (l + 1) * U_LAYER);
    p0_plain(F, gw, NGW, 0, (F.G == 256) ? 1 : NL);
    for (int r = gw; r < NL * PG * 128; r += NGW) {
        const float* wp = inp(F, 9) + (size_t)(r >> 7) * 128 * 128 + (r & 127);
        ((GAS unsigned*)(F.ws + WS_WPT))[(size_t)r * 64 + F.lane] = cvt_pk_bf16(wp[(2 * F.lane) * 128], wp[(2 * F.lane + 1) * 128]); }
    for (int r = gw; r < NL * GH * CH; r += NGW) {
        const int t = r & 127; const f32x2 w2 = *(const GAS f32x2*)(inp(F, 7) + (size_t)r * CH + 2 * F.lane);
        ((GAS unsigned*)(F.ws + WS_WSM))[(size_t)r * 64 + F.lane] = cvt_pk_bf16(2 * F.lane <= t ? w2.x : 0.f, 2 * F.lane + 1 <= t ? w2.y : 0.f); }
    p0_memnorm(F, gw, NGW, 0, NL);
    for (int m0 = gw; m0 < M; m0 += 4 * NGW) {
        f32x4 v[4][8];
#pragma unroll
        for (int r = 0; r < 4; ++r) { const int m = m0 + r * NGW; if (m < M) { const GAS f32x4* xr = (const GAS f32x4*)(inp(F, 0) + (size_t)m * D) + F.lane;
#pragma unroll
            for (int j = 0; j < 8; ++j) v[r][j] = xr[64 * j]; } }
#pragma unroll
        for (int r = 0; r < 4; ++r) { const int m = m0 + r * NGW; if (m < M) { float s = 0.f;
#pragma unroll
            for (int j = 0; j < 8; ++j) s += (v[r][j].x * v[r][j].x + v[r][j].y * v[r][j].y) + (v[r][j].z * v[r][j].z + v[r][j].w * v[r][j].w);
            const float rs = 1.f / sqrtf(wave_sum(s) * (1.f / D) + RMS_EPS);
            const GAS f32x4* g4 = (const GAS f32x4*)inp(F, 2) + F.lane; GAS u32x2* o8 = (GAS u32x2*)((bf16_t*)(F.ws + WS_XN) + (size_t)m * D) + F.lane;
#pragma unroll
            for (int j = 0; j < 8; ++j) { const f32x4 gg = g4[64 * j]; u32x2 w; w.x = cvt_pk_bf16(v[r][j].x * rs * gg.x, v[r][j].y * rs * gg.y); w.y = cvt_pk_bf16(v[r][j].z * rs * gg.z, v[r][j].w * rs * gg.w); o8[64 * j] = w; } } }
    }
}

template <bool IN_F32, bool OUT_F32>
__device__ __forceinline__ void norm_pass(Frame& F, const float* g_post, const float* g_pre) {
    refresh(F);
    const int gw = F.vcu * NWAVES + F.wave, NGW = F.G * NWAVES;
    const bf16_t* HB = (const bf16_t*)(F.ws + WS_HB); bf16_t* XN = (bf16_t*)(F.ws + WS_XN); unsigned short* XH = (unsigned short*)(F.ws + WS_XH);
    constexpr int NR = IN_F32 ? 2 : 4;
    for (int m0 = gw; m0 < M; m0 += NR * NGW) {
        u32x2 hw[NR][8]; f32x4 xf[IN_F32 ? NR : 1][8]; u32x2 xw[IN_F32 ? 1 : NR][8];
#pragma unroll
        for (int r = 0; r < NR; ++r) { const int m = m0 + r * NGW; if (m < M) {
            const GAS u32x2* hr = (const GAS u32x2*)(HB + (size_t)m * D) + F.lane;
            if constexpr (IN_F32) { const GAS f32x4* xi = (const GAS f32x4*)(inp(F, 0) + (size_t)m * D) + F.lane;
#pragma unroll
                for (int j = 0; j < 8; ++j) xf[IN_F32 ? r : 0][j] = __builtin_nontemporal_load(xi + 64 * j); }
            else { const GAS u32x2* xi = (const GAS u32x2*)(XH + (size_t)m * D) + F.lane;
#pragma unroll
                for (int j = 0; j < 8; ++j) xw[IN_F32 ? 0 : r][j] = __builtin_nontemporal_load(xi + 64 * j); }
#pragma unroll
            for (int j = 0; j < 8; ++j) hw[r][j] = __builtin_nontemporal_load(hr + 64 * j); } }
#pragma unroll
        for (int r = 0; r < NR; ++r) { const int m = m0 + r * NGW; if (m < M) {
            const GAS f32x4* gp = (const GAS f32x4*)g_post + F.lane;
            f32x4 h[8], x[8]; float s = 0.f;
#pragma unroll
            for (int j = 0; j < 8; ++j) { const u32x2 w = hw[r][j]; h[j] = (f32x4){bf_lo(w.x), bf_hi(w.x), bf_lo(w.y), bf_hi(w.y)}; s += (h[j].x * h[j].x + h[j].y * h[j].y) + (h[j].z * h[j].z + h[j].w * h[j].w);
                if constexpr (IN_F32) x[j] = xf[IN_F32 ? r : 0][j]; else { const f32x2 a = unpk_f16(xw[IN_F32 ? 0 : r][j].x), b = unpk_f16(xw[IN_F32 ? 0 : r][j].y); x[j] = (f32x4){a.x, a.y, b.x, b.y}; } }
            const float rs = 1.f / sqrtf(wave_sum(s) * (1.f / D) + RMS_EPS); float s2 = 0.f;
#pragma unroll
            for (int j = 0; j < 8; ++j) { const f32x4 g = gp[64 * j]; x[j] = x[j] + h[j] * rs * g;
                if constexpr (OUT_F32) ((GAS f32x4*)(F.out + (size_t)m * D) + F.lane)[64 * j] = x[j];
                else { u32x2 w; w.x = pk_f16(x[j].x, x[j].y); w.y = pk_f16(x[j].z, x[j].w); ((GAS u32x2*)(XH + (size_t)m * D) + F.lane)[64 * j] = w; }
                s2 += (x[j].x * x[j].x + x[j].y * x[j].y) + (x[j].z * x[j].z + x[j].w * x[j].w); }
            if (g_pre) {
                const float rs2 = 1.f / sqrtf(wave_sum(s2) * (1.f / D) + RMS_EPS);
                const GAS f32x4* g4 = (const GAS f32x4*)g_pre + F.lane; GAS u32x2* o8 = (GAS u32x2*)(XN + (size_t)m * D) + F.lane;
#pragma unroll
                for (int j = 0; j < 8; ++j) { const f32x4 gg = g4[64 * j]; u32x2 w; w.x = cvt_pk_bf16(x[j].x * rs2 * gg.x, x[j].y * rs2 * gg.y); w.y = cvt_pk_bf16(x[j].z * rs2 * gg.z, x[j].w * rs2 * gg.w); o8[64 * j] = w; }
            } } }
    }
}

constexpr int LDP = 136;
__device__ __forceinline__ void small_mma(const LAS bf16_t* Tm, const LAS bf16_t* Dm, int wave, int fr, int fq, f32x4 (&acc)[8]) {
#pragma unroll
    for (int dt = 0; dt < 8; ++dt) acc[dt] = (f32x4){0.f, 0.f, 0.f, 0.f};
#pragma unroll
    for (int k = 0; k < 4; ++k) {
        const bf16x8 y = *(const LAS bf16x8*)(Tm + (16 * wave + fr) * LDP + 32 * k + 8 * fq);
#pragma unroll
        for (int dt = 0; dt < 8; ++dt) { const bf16x8 x = *(const LAS bf16x8*)(Dm + (32 * (dt >> 1) + 8 * (fr >> 2) + 4 * (dt & 1) + (fr & 3)) * LDP + 32 * k + 8 * fq);
            acc[dt] = __builtin_amdgcn_mfma_f32_16x16x32_bf16(x, y, acc[dt], 0, 0, 0); }
    }
}
__device__ __forceinline__ void gmlp_pair(Frame& F, int l, int pair) {
    refresh(F);
    const int bc = pair >> 3, h = pair & 7, tid = F.tid;
    LAS bf16_t* Wm = (LAS bf16_t*)F.lds; LAS bf16_t* vT0 = Wm + 128 * LDP; LAS bf16_t* vT1 = vT0 + 128 * LDP;
    const bf16_t* Z = (const bf16_t*)(F.ws + WS_BIG + BO_Z); bf16_t* Y = (bf16_t*)(F.ws + WS_BIG + BO_Y);
    const int t = tid >> 2, q4 = tid & 3;
    const int fr = F.lane & 15, fq = F.lane >> 4;
    const int tt = 16 * F.wave + fr;
    u32x4 uw[2][4];
#pragma unroll
    for (int p2 = 0; p2 < 2; ++p2) { const bf16_t* urow = Z + (size_t)((bc + 32 * p2) * CH + tt) * NIN + h * HD + 8 * fq;
#pragma unroll
        for (int j = 0; j < 4; ++j) uw[p2][j] = *(const GAS u32x4*)(urow + 32 * j); }
    {
        const GAS u32x4* wsrc = (const GAS u32x4*)((const bf16_t*)(F.ws + WS_WSM) + ((size_t)(l * GH + h) * CH + t) * CH + q4 * 32);
#pragma unroll
        for (int j = 0; j < 4; ++j) *(LAS u32x4*)(Wm + t * LDP + q4 * 32 + 8 * j) = wsrc[j];
    }
    {
        const GAS f32x4* gv4 = (const GAS f32x4*)(inp(F, 6) + (l * GH + h) * HD + q4 * 32); float gv[32];
#pragma unroll
        for (int i = 0; i < 8; ++i) { const f32x4 g = gv4[i]; gv[4 * i] = g.x; gv[4 * i + 1] = g.y; gv[4 * i + 2] = g.z; gv[4 * i + 3] = g.w; }
        u32x4 vw[2][4];
#pragma unroll
        for (int p2 = 0; p2 < 2; ++p2) { const GAS u32x4* vsrc = (const GAS u32x4*)(Z + (size_t)((bc + 32 * p2) * CH + t) * NIN + GW + h * HD + q4 * 32);
#pragma unroll
            for (int j = 0; j < 4; ++j) vw[p2][j] = vsrc[j]; }
#pragma unroll
        for (int p2 = 0; p2 < 2; ++p2) { LAS bf16_t* vT = p2 ? vT1 : vT0;
            float v[32]; float sum = 0.f;
#pragma unroll
            for (int j = 0; j < 4; ++j) { const u32x4 w = vw[p2][j];
                v[8 * j + 0] = bf_lo(w.x); v[8 * j + 1] = bf_hi(w.x); v[8 * j + 2] = bf_lo(w.y); v[8 * j + 3] = bf_hi(w.y); v[8 * j + 4] = bf_lo(w.z); v[8 * j + 5] = bf_hi(w.z); v[8 * j + 6] = bf_lo(w.w); v[8 * j + 7] = bf_hi(w.w); }
#pragma unroll
            for (int i = 0; i < 32; ++i) sum += v[i];
            sum += lx1(sum); sum += lx2(sum);
            const float mu = sum * (1.f / HD); float q = 0.f;
#pragma unroll
            for (int i = 0; i < 32; ++i) { v[i] -= mu; q += v[i] * v[i]; }
            q += lx1(q); q += lx2(q);
            const float rs = 1.f / sqrtf(q * (1.f / HD) + LN_EPS);
#pragma unroll
            for (int i = 0; i < 32; i += 2) { const unsigned w = cvt_pk_bf16(v[i] * rs * gv[i], v[i + 1] * rs * gv[i + 1]);
                vT[(q4 * 32 + i) * LDP + t] = (bf16_t)(w & 0xffffu); vT[(q4 * 32 + i + 1) * LDP + t] = (bf16_t)(w >> 16); } }
    }
    __syncthreads();
    f32x4 acc0[8], acc1[8];
#pragma unroll
    for (int dt = 0; dt < 8; ++dt) { acc0[dt] = (f32x4){0.f, 0.f, 0.f, 0.f}; acc1[dt] = (f32x4){0.f, 0.f, 0.f, 0.f}; }
#pragma unroll
    for (int k = 0; k < 4; ++k) {
        const bf16x8 y = *(const LAS bf16x8*)(Wm + (16 * F.wave + fr) * LDP + 32 * k + 8 * fq);
#pragma unroll
        for (int dt = 0; dt < 8; ++dt) { const int drow = (32 * (dt >> 1) + 8 * (fr >> 2) + 4 * (dt & 1) + (fr & 3)) * LDP + 32 * k + 8 * fq;
            acc0[dt] = __builtin_amdgcn_mfma_f32_16x16x32_bf16(*(const LAS bf16x8*)(vT0 + drow), y, acc0[dt], 0, 0, 0);
            acc1[dt] = __builtin_amdgcn_mfma_f32_16x16x32_bf16(*(const LAS bf16x8*)(vT1 + drow), y, acc1[dt], 0, 0, 0); }
    }
    {
        const float bsv = inp(F, 8)[(l * GH + h) * CH + tt];
#pragma unroll
        for (int p2 = 0; p2 < 2; ++p2) { bf16_t* yrow = Y + (size_t)((bc + 32 * p2) * CH + tt) * D + h * HD + 8 * fq;
#pragma unroll
            for (int j = 0; j < 4; ++j) { const f32x4 a = p2 ? acc1[2 * j] : acc0[2 * j], b = p2 ? acc1[2 * j + 1] : acc0[2 * j + 1]; const u32x4 uu = uw[p2][j];
                u32x4 o; o.x = cvt_pk_bf16(bf_lo(uu.x) * (a[0] + bsv), bf_hi(uu.x) * (a[1] + bsv)); o.y = cvt_pk_bf16(bf_lo(uu.y) * (a[2] + bsv), bf_hi(uu.y) * (a[3] + bsv));
                o.z = cvt_pk_bf16(bf_lo(uu.z) * (b[0] + bsv), bf_hi(uu.z) * (b[1] + bsv)); o.w = cvt_pk_bf16(bf_lo(uu.w) * (b[2] + bsv), bf_hi(uu.w) * (b[3] + bsv));
                *(GAS u32x4*)(yrow + 32 * j) = o; } }
    }
    __syncthreads();
}
struct PoolRegs { u32x4 z[5]; u32x4 w[4]; };
__device__ __forceinline__ void pool_load(Frame& F, int l, int unit, PoolRegs& R) {
    refresh(F);
    const int bc = unit >> 2, g = unit & 3, row0 = bc * CH, cseq = bc & 15, tid = F.tid;
    const bf16_t* Z = (const bf16_t*)(F.ws + WS_BIG + BO_Z);
#pragma unroll
    for (int k = 0; k < 5; ++k) { const int ch = tid + 512 * k, i = ch >> 4, c16 = ch & 15; R.z[k] = (u32x4){0u, 0u, 0u, 0u};
        if (ch < 144 * 16 && (cseq > 0 || i >= 16)) R.z[k] = *(const GAS u32x4*)(Z + (size_t)(row0 - 16 + i) * NIN + 2 * GW + g * 128 + c16 * 8); }
    const int d = tid >> 2, q4 = tid & 3; const GAS u32x4* wsrc = (const GAS u32x4*)((const bf16_t*)(F.ws + WS_WPT) + ((size_t)(l * PG + g) * 128 + d) * 128 + q4 * 32);
#pragma unroll
    for (int j = 0; j < 4; ++j) R.w[j] = wsrc[j];
}
__device__ __forceinline__ void pool_unit(Frame& F, int l, int unit, const PoolRegs& R) {
    refresh(F);
    const int bc = unit >> 2, g = unit & 3, row0 = bc * CH, cseq = bc & 15, w = 2 << g, tid = F.tid;
    LAS unsigned* Pt = (LAS unsigned*)F.lds;
    LAS bf16_t* Pl = (LAS bf16_t*)(F.lds + 36864); LAS bf16_t* WpT = Pl + 128 * LDP;
    bf16_t* Y = (bf16_t*)(F.ws + WS_BIG + BO_Y);
#pragma unroll
    for (int k = 0; k < 5; ++k) { const int ch = tid + 512 * k, i = ch >> 4, c16 = ch & 15; if (ch < 144 * 16) *(LAS u32x4*)(Pt + i * 64 + c16 * 4) = R.z[k]; }
    {
        const int d = tid >> 2, q4 = tid & 3;
#pragma unroll
        for (int j = 0; j < 4; ++j) *(LAS u32x4*)(WpT + d * LDP + q4 * 32 + 8 * j) = R.w[j];
    }
    __syncthreads();
    {
        const int cp = tid & 63, tg = tid >> 6, i0 = tg * 16 + 16;
        float s0 = 0.f, s1 = 0.f;
        for (int j = 1; j < w; ++j) { const unsigned d = Pt[(i0 - j) * 64 + cp]; s0 += bf_lo(d); s1 += bf_hi(d); }
#pragma unroll
        for (int tt = 0; tt < 16; ++tt) { const int t = tg * 16 + tt, i = t + 16, pos = cseq * CH + t;
            const unsigned self = Pt[i * 64 + cp]; s0 += bf_lo(self); s1 += bf_hi(self);
            const float inv = 1.f / (float)((pos + 1) < w ? (pos + 1) : w);
            ((LAS unsigned*)Pl)[t * (LDP / 2) + cp] = cvt_pk_bf16(s0 * inv - bf_lo(self), s1 * inv - bf_hi(self));
            const unsigned old = Pt[(i - w + 1) * 64 + cp]; s0 -= bf_lo(old); s1 -= bf_hi(old); }
    }
    __syncthreads();
    const int fr = F.lane & 15, fq = F.lane >> 4;
    f32x4 acc[8];
    small_mma(Pl, WpT, F.wave, fr, fq, acc);
    {
        const int tt = 16 * F.wave + fr; const float* sp = inp(F, 10) + l * PW + g * 128 + 8 * fq; bf16_t* yrow = Y + (size_t)(row0 + tt) * D + GW + g * 128 + 8 * fq;
#pragma unroll
        for (int j = 0; j < 4; ++j) { const f32x4 s0 = *(const GAS f32x4*)(sp + 32 * j), s1 = *(const GAS f32x4*)(sp + 32 * j + 4); const f32x4 a = acc[2 * j], b = acc[2 * j + 1];
            u32x4 o; o.x = cvt_pk_bf16(a[0] * s0.x, a[1] * s0.y); o.y = cvt_pk_bf16(a[2] * s0.z, a[3] * s0.w); o.z = cvt_pk_bf16(b[0] * s1.x, b[1] * s1.y); o.w = cvt_pk_bf16(b[2] * s1.z, b[3] * s1.w);
            *(GAS u32x4*)(yrow + 32 * j) = o; }
    }
    __syncthreads();
}
constexpr int CT = 32, CR = CT + CK - 1;
template <int I> __device__ __forceinline__ void conv_taps(float (&acc)[CT], const float (&wj)[CK], const LAS bf16_t* Hc) {
    if constexpr (I < CR) {
        const float hv = __builtin_bit_cast(float, (unsigned)Hc[I * 512] << 16);
        constexpr int T0 = (I - (CK - 1) > 0) ? I - (CK - 1) : 0, T1 = (I < CT - 1) ? I : CT - 1;
#pragma unroll
        for (int t = T0; t <= T1; ++t) acc[t] += wj[I - t] * hv;
        conv_taps<I + 1>(acc, wj, Hc);
    }
}
constexpr int CONV_NP = CR * 64, CONV_NK = (CONV_NP + 511) / 512;
struct ConvRegs { u32x4 cv[CONV_NK], cg[CONV_NK]; };
__device__ __forceinline__ void conv_load(Frame& F, int unit, ConvRegs& R) {
    refresh(F);
    const int row0 = unit * CT, pos0 = row0 & (SEQ - 1), c = F.tid;
    const bf16_t* Z = (const bf16_t*)(F.ws + WS_BIG + BO_Z);
#pragma unroll
    for (int k = 0; k < CONV_NK; ++k) { const int p = (c + 512 * k < CONV_NP) ? c + 512 * k : c; const int i = p >> 6, grp = p & 63; const bool ok = (pos0 - (CK - 1) + i) >= 0;
        const bf16_t* zr = Z + (size_t)(ok ? row0 - (CK - 1) + i : row0) * NIN + 2 * GW + PW + 8 * grp;
        R.cv[k] = *(const GAS u32x4*)zr; R.cg[k] = *(const GAS u32x4*)(zr + CW); }
}
__device__ __forceinline__ void conv_unit(Frame& F, int l, int unit, const float (&wj)[CK], const ConvRegs& R) {
    refresh(F);
    const int row0 = unit * CT, pos0 = row0 & (SEQ - 1), c = F.tid;
    bf16_t* Y = (bf16_t*)(F.ws + WS_BIG + BO_Y);
    LAS bf16_t* H = (LAS bf16_t*)F.lds;
    LAS float* CV = (LAS float*)(F.lds + CR * 512 * 2);
    {
        constexpr int NP = CONV_NP, NK = CONV_NK;
        const u32x4 (&cv)[NK] = R.cv; const u32x4 (&cg)[NK] = R.cg;
#pragma unroll
        for (int k = 0; k < NK; ++k) { const int p = c + 512 * k; if (p < NP) { const int i = p >> 6, grp = p & 63; const float ok = (pos0 - (CK - 1) + i) >= 0 ? 1.f : 0.f;
            u32x4 o;
            o.x = cvt_pk_bf16(ok * bf_lo(cv[k].x) * fast_sigmoid(bf_lo(cg[k].x)), ok * bf_hi(cv[k].x) * fast_sigmoid(bf_hi(cg[k].x)));
            o.y = cvt_pk_bf16(ok * bf_lo(cv[k].y) * fast_sigmoid(bf_lo(cg[k].y)), ok * bf_hi(cv[k].y) * fast_sigmoid(bf_hi(cg[k].y)));
            o.z = cvt_pk_bf16(ok * bf_lo(cv[k].z) * fast_sigmoid(bf_lo(cg[k].z)), ok * bf_hi(cv[k].z) * fast_sigmoid(bf_hi(cg[k].z)));
            o.w = cvt_pk_bf16(ok * bf_lo(cv[k].w) * fast_sigmoid(bf_lo(cg[k].w)), ok * bf_hi(cv[k].w) * fast_sigmoid(bf_hi(cg[k].w)));
            *(LAS u32x4*)(H + i * 512 + 8 * grp) = o; } }
    }
    __syncthreads();
    float acc[CT];
#pragma unroll
    for (int t = 0; t < CT; ++t) acc[t] = 0.f;
    conv_taps<0>(acc, wj, H + c);
    const float bd = inp(F, 12)[l * CW + c];
#pragma unroll
    for (int t = 0; t < CT; ++t) CV[t * 512 + c] = acc[t] + bd;
    __syncthreads();
    const GAS f32x4* lg = (const GAS f32x4*)(inp(F, 13) + l * CW) + 2 * F.lane; const GAS f32x4* lb = (const GAS f32x4*)(inp(F, 14) + l * CW) + 2 * F.lane;
    const f32x4 g0 = lg[0], g1 = lg[1], b0 = lb[0], b1 = lb[1];
#pragma unroll
    for (int k = 0; k < CT / 8; ++k) { const int t = (CT / 8) * F.wave + k;
        f32x4 a = *(const LAS f32x4*)(CV + t * 512 + 8 * F.lane), b = *(const LAS f32x4*)(CV + t * 512 + 8 * F.lane + 4);
        const float mu = wave_sum((a.x + a.y) + (a.z + a.w) + (b.x + b.y) + (b.z + b.w)) * (1.f / CW);
        a = a - mu; b = b - mu;
        const float var = wave_sum((a.x * a.x + a.y * a.y) + (a.z * a.z + a.w * a.w) + (b.x * b.x + b.y * b.y) + (b.z * b.z + b.w * b.w)) * (1.f / CW);
        const float rs = 1.f / sqrtf(var + LN_EPS);
        a = a * rs * g0 + b0; b = b * rs * g1 + b1;
        u32x4 o; o.x = cvt_pk_bf16(a.x * fast_sigmoid(a.x), a.y * fast_sigmoid(a.y)); o.y = cvt_pk_bf16(a.z * fast_sigmoid(a.z), a.w * fast_sigmoid(a.w));
        o.z = cvt_pk_bf16(b.x * fast_sigmoid(b.x), b.y * fast_sigmoid(b.y)); o.w = cvt_pk_bf16(b.z * fast_sigmoid(b.z), b.w * fast_sigmoid(b.w));
        *(GAS u32x4*)(Y + (size_t)(row0 + t) * D + GW + PW + 8 * F.lane) = o; }
    __syncthreads();
}
static_assert((M / CH) * GH / 2 == 256 && (M / CH) * PG == 256 && M / CT == 256, "the three mixers have 256 units each");
__device__ __forceinline__ void mixer_phase(Frame& F, int l) {
    float wj[CK]; { const float* wdw = inp(F, 11) + (size_t)l * CK * CW + fresh_tid();
#pragma unroll
        for (int j = 0; j < CK; ++j) wj[j] = wdw[j * CW]; }
    for (int u = F.vcu; u < 256; u += F.G) {
        PoolRegs PR; pool_load(F, l, u, PR);
        gmlp_pair(F, l, u);
        ConvRegs CRg; conv_load(F, u, CRg);
        pool_unit(F, l, u, PR);
        conv_unit(F, l, u, wj, CRg);
    }
}

struct Args { const float* in[26]; float* out; unsigned char* ws; int stop, rep; };
__global__ void __launch_bounds__(NWAVES * 64, 2) mega_fwd(Args args) {
    extern __shared__ __attribute__((aligned(16))) unsigned char lds[];
    Frame F;
    F.lds = (LAS unsigned char*)lds;
    F.tid = threadIdx.x; F.lane = F.tid & 63; F.wave = __builtin_amdgcn_readfirstlane(F.tid >> 6);
    F.G = gridDim.x; { const int bx = blockIdx.x; F.vcu = (F.G % 8 == 0) ? (bx % 8) * (F.G / 8) + bx / 8 : bx; }
    F.kp = __builtin_amdgcn_kernarg_segment_ptr();
    F.out = args.out; F.ws = args.ws;
    for (int u = F.tid; u < (LDS_BYTES - LDSCTL_OFF) / 4; u += NWAVES * 64) ((LAS unsigned*)(F.lds + LDSCTL_OFF))[u] = 0u;
    __syncthreads();
    const XcdBarrier bar = xcd_barrier_post((unsigned*)(F.ws + WS_CTL) + CW_BAR, (volatile LAS unsigned*)(F.lds + MISC_OFF) + 8);
#define GRID_BAR() do { xcd_barrier(bar); if (++ph >= args.stop) return; } while (0)
    int ph = 0;
    const int cid0 = (int)blockIdx.x;
#define cid opaque_s(cid0)
    const char* XN = (const char*)(F.ws + WS_XN); float* HB = (float*)(F.ws + WS_HB);
    unsigned char* BIG = F.ws + WS_BIG;

    for (int r_ = 0; r_ < (args.rep == 0 ? 2 : 1); ++r_) p0_prologue(F);
    if (args.rep == 100) for (int r_ = 0; r_ < 50; ++r_) xcd_barrier(bar);
    GRID_BAR();
    for (int l = 0; l < NL; ++l) {
        const unsigned char* wl = F.ws + WS_W + (size_t)l * W_LAYER;
        const char* MN = (const char*)(F.ws + WS_MN) + (size_t)l * MM * D * 2;
        for (int r_ = 0; r_ < (args.rep == 1 ? 2 : 1); ++r_)
        { SchedIn S{(const char*)F.ws, (const char*)wl, MN, F.G, cid};
          pg8::gemm_phase<pg8::EpiBf16<1>, SchedIn>(F.lds, D, D, S, pg8::EpiBf16<1>{}); }
        GRID_BAR();
        for (int r_ = 0; r_ < (args.rep == 2 ? 2 : 1); ++r_) mixer_phase(F, l);
        GRID_BAR();
        for (int r_ = 0; r_ < (args.rep == 3 ? 2 : 1); ++r_)
        { SchedGU S{(const char*)F.ws, (const char*)wl, F.G, cid}; pg8::gemm_phase<pg8::EpiBf16<0>, SchedGU>(F.lds, D, D, S, pg8::EpiBf16<0>{}); }
        GRID_BAR();
        if (l == 0) norm_pass<true, false>(F, inp(F, 3) + l * D, inp(F, 15) + l * D); else norm_pass<false, false>(F, inp(F, 3) + l * D, inp(F, 15) + l * D);
        GRID_BAR();
        for (int r_ = 0; r_ < (args.rep == 6 ? 2 : 1); ++r_) {
        { SchedS S{XN, (const char*)(BIG + BO_GT), BIG + BO_P, F.G, cid};
          pg8::gemm_phase<pg8::EpiSoftmax, SchedS>(F.lds, D, D, S, pg8::EpiSoftmax{0.044194173824159216f * 1.44269504089f}); }
        if (F.G == 256) {
            refresh(F); const int lo = l * U_LAYER + U_EARLY, mid = lo + (l == 0 ? U_IDLE_SHARE : U_IDLE_SHARE_L1), hi = (l + 1) * U_LAYER;
            if (cid0 >= 128) { p0_convert(F, (cid0 - 128) * NWAVES + F.wave, 128 * NWAVES, lo, mid); if (l == 0) { p0_convert(F, (cid0 - 128) * NWAVES + F.wave, 128 * NWAVES, U_LAYER + U_EARLY - U_L1_IN_S0, U_LAYER + U_EARLY); p0_plain(F, (cid0 - 128) * NWAVES + F.wave, 128 * NWAVES, 1, NL); } }
            else { __syncthreads();   p0_convert(F, cid0 * NWAVES + F.wave, 128 * NWAVES, mid, hi); } }
        }
        GRID_BAR();
        for (int r_ = 0; r_ < (args.rep == 8 ? 2 : 1); ++r_)
        { SchedO S{(const char*)(BIG + BO_P), (const char*)(BIG + BO_UT), HB, F.G, cid};
          pg8::gemm_phase<pg8::EpiBf16<0>, SchedO>(F.lds, XH * MEM, XH * MEM, S, pg8::EpiBf16<0>{}); }
        GRID_BAR();
        norm_pass<false, false>(F, inp(F, 17) + l * D, inp(F, 22) + l * D);
        GRID_BAR();
        for (int r_ = 0; r_ < (args.rep == 10 ? 2 : 1); ++r_)
        { typedef SchedPlain<D, D, FF, M / 256, FF / 256, D> SP; SP S{XN, (const char*)(wl + WO_UP), BIG + BO_UP, F.G, cid};
          pg8::gemm_phase<pg8::EpiBf16<2>, SP>(F.lds, D, D, S, pg8::EpiBf16<2>{}); }
        GRID_BAR();
        for (int r_ = 0; r_ < (args.rep == 11 ? 2 : 1); ++r_)
        { typedef SchedPlain<FF, FF, D, M / 256, D / 256, FF> SP; SP S{(const char*)(BIG + BO_UP), (const char*)(wl + WO_DN), HB, F.G, cid};
          pg8::gemm_phase<pg8::EpiBf16<0>, SP>(F.lds, FF, FF, S, pg8::EpiBf16<0>{}); }
        GRID_BAR();
        if (l + 1 < NL) norm_pass<false, false>(F, inp(F, 23) + l * D, inp(F, 2) + (l + 1) * D); else norm_pass<false, true>(F, inp(F, 23) + l * D, nullptr);
        if (l + 1 < NL) GRID_BAR();
    }
}


#ifndef DBG_CUT
#define DBG_CUT 6
#endif
#ifndef PROBE_REP
#define PROBE_REP -1
#endif
#if DBG_CUT < 6
namespace nv {
constexpr int D = 2048, B = 4, S = 2048, L = 2, MEM = 256, HD = 128, CH = 128;
constexpr int GW = 1024, PW = 512, CW = 512, NIN = 3584, GH = 8, PG = 4, CK = 31, XH = 4, XD = 512, FF = 8192;
constexpr int M = B * S, MM = B * MEM;
constexpr float RMS_EPS = 1e-6f, LN_EPS = 1e-5f;

__device__ __forceinline__ float gelu_tanh(float x) { const float u = 0.7978845608028654f * (x + 0.044715f * x * x * x); return 0.5f * x * (1.f + tanhf(u)); }
__device__ __forceinline__ float sigmoidf(float x) { return 1.f / (1.f + expf(-x)); }

__device__ __forceinline__ float block_sum(float v, float* red) {
    for (int o = 32; o > 0; o >>= 1) v += __shfl_xor(v, o);
    __syncthreads();
    if ((threadIdx.x & 63) == 0) red[threadIdx.x >> 6] = v;
    __syncthreads();
    float s = 0.f; for (int i = 0; i < (int)(blockDim.x >> 6); ++i) s += red[i];
    return s;
}

template <int ACC> __global__ void __launch_bounds__(256) k_rmsnorm(const float* in, const float* g, float* out, int ncols) {
    __shared__ float red[8];
    const float* r = in + (size_t)blockIdx.x * ncols; float* o = out + (size_t)blockIdx.x * ncols;
    float s = 0.f; for (int c = threadIdx.x; c < ncols; c += 256) { const float v = r[c]; s += v * v; }
    s = block_sum(s, red);
    const float rs = rsqrtf(s / ncols + RMS_EPS);
    for (int c = threadIdx.x; c < ncols; c += 256) { const float v = r[c] * rs * g[c]; if (ACC) o[c] += v; else o[c] = v; }
}

template <int EPI> __global__ void __launch_bounds__(256) k_gemm(const float* A, const float* Bm, float* C, int Mr, int N, int K, int ngelu) {
    __shared__ float As[16][65], Bs[16][65];
    const int tx = threadIdx.x & 15, ty = threadIdx.x >> 4, m0 = blockIdx.y * 64, n0 = blockIdx.x * 64;
    float acc[4][4] = {};
    for (int k0 = 0; k0 < K; k0 += 16) {
        for (int i = threadIdx.x; i < 1024; i += 256) { const int r = i >> 4, c = i & 15; As[c][r] = A[(size_t)(m0 + r) * K + k0 + c]; }
        for (int i = threadIdx.x; i < 1024; i += 256) { const int r = i >> 6, c = i & 63; Bs[r][c] = Bm[(size_t)(k0 + r) * N + n0 + c]; }
        __syncthreads();
#pragma unroll
        for (int kk = 0; kk < 16; ++kk) {
            float a[4], b[4];
#pragma unroll
            for (int i = 0; i < 4; ++i) { a[i] = As[kk][ty * 4 + i]; b[i] = Bs[kk][tx * 4 + i]; }
#pragma unroll
            for (int i = 0; i < 4; ++i)
#pragma unroll
                for (int j = 0; j < 4; ++j) acc[i][j] += a[i] * b[j];
        }
        __syncthreads();
    }
#pragma unroll
    for (int i = 0; i < 4; ++i)
#pragma unroll
        for (int j = 0; j < 4; ++j) {
            const int r = m0 + ty * 4 + i, c = n0 + tx * 4 + j; float v = acc[i][j];
            if (EPI == 1) { if (c < ngelu) v = gelu_tanh(v); }
            if (EPI == 2) { v = v > 0.f ? v * v : 0.f; }
            C[(size_t)r * N + c] = v;
        }
}

__global__ void __launch_bounds__(256) k_gmlp(const float* z, const float* gv, const float* ws, const float* bs, float* y) {
    __shared__ float v[128][129];
    const int cb = blockIdx.x, h = blockIdx.y, row0 = cb * CH, tid = threadIdx.x;
    for (int i = tid; i < 128 * 128; i += 256) { const int s = i >> 7, d = i & 127; v[s][d] = z[(size_t)(row0 + s) * NIN + GW + h * HD + d]; }
    __syncthreads();
    if (tid < 128) {
        float mu = 0.f; for (int d = 0; d < 128; ++d) mu += v[tid][d]; mu *= (1.f / 128.f);
        float var = 0.f; for (int d = 0; d < 128; ++d) { const float e = v[tid][d] - mu; var += e * e; } var *= (1.f / 128.f);
        const float rs = rsqrtf(var + LN_EPS);
        for (int d = 0; d < 128; ++d) v[tid][d] = (v[tid][d] - mu) * rs * gv[h * HD + d];
    }
    __syncthreads();
    const int d = tid & 127, th = tid >> 7;
    for (int t = th * 64; t < th * 64 + 64; ++t) {
        const float* w = ws + ((size_t)h * CH + t) * CH; float acc = 0.f;
        for (int s = 0; s <= t; ++s) acc += w[s] * v[s][d];
        acc += bs[h * CH + t];
        const size_t r = (size_t)(row0 + t);
        y[r * D + h * HD + d] = z[r * NIN + h * HD + d] * acc;
    }
}

__global__ void __launch_bounds__(256) k_pool(const float* z, const float* wp, const float* sp, float* y) {
    __shared__ float pl[64][129];
    const int tb = blockIdx.x, g = blockIdx.y, row0 = tb * 64, tid = threadIdx.x;
    const int wins[4] = {2, 4, 8, 16}; const int w = wins[g];
    for (int i = tid; i < 64 * 128; i += 256) {
        const int tt = i >> 7, c = i & 127, row = row0 + tt, t = row % S;
        float sum = 0.f; const int lo = (t - w + 1) < 0 ? 0 : (t - w + 1);
        for (int s = lo; s <= t; ++s) sum += z[(size_t)(row - t + s) * NIN + 2 * GW + g * 128 + c];
        const float cnt = (float)((t + 1) < w ? (t + 1) : w);
        pl[tt][c] = sum / cnt - z[(size_t)row * NIN + 2 * GW + g * 128 + c];
    }
    __syncthreads();
    const int d = tid & 127, th = tid >> 7;
    for (int tt = th * 32; tt < th * 32 + 32; ++tt) {
        float acc = 0.f; for (int c = 0; c < 128; ++c) acc += pl[tt][c] * wp[((size_t)g * 128 + c) * 128 + d];
        y[(size_t)(row0 + tt) * D + GW + g * 128 + d] = acc * sp[g * 128 + d];
    }
}

__global__ void __launch_bounds__(512) k_conv(const float* z, const float* wdw, const float* bdw, const float* lg, const float* lb, float* y) {
    __shared__ float red[8];
    const int row = blockIdx.x, t = row % S, c = threadIdx.x;
    float acc = 0.f;
    for (int j = 0; j < CK; ++j) { const int ts = t + j - (CK - 1); if (ts < 0) continue; const size_t r = (size_t)(row - t + ts);
        const float cv = z[r * NIN + 2 * GW + PW + c], cg = z[r * NIN + 2 * GW + PW + CW + c]; acc += wdw[j * CW + c] * (cv * sigmoidf(cg)); }
    acc += bdw[c];
    float s = acc; for (int o = 32; o > 0; o >>= 1) s += __shfl_xor(s, o);
    if ((c & 63) == 0) red[c >> 6] = s; __syncthreads();
    float mu = 0.f; for (int i = 0; i < 8; ++i) mu += red[i]; mu *= (1.f / 512.f);
    __syncthreads();
    const float e = acc - mu; float q = e * e; for (int o = 32; o > 0; o >>= 1) q += __shfl_xor(q, o);
    if ((c & 63) == 0) red[c >> 6] = q; __syncthreads();
    float var = 0.f; for (int i = 0; i < 8; ++i) var += red[i]; var *= (1.f / 512.f);
    const float ln = e * rsqrtf(var + LN_EPS) * lg[c] + lb[c];
    y[(size_t)row * D + GW + PW + c] = ln * sigmoidf(ln);
}

__global__ void __launch_bounds__(256) k_attn(const float* q, const float* kk, const float* vv, float* o) {
    __shared__ float qs[512], p[256], red[8];
    const int row = blockIdx.x, h = blockIdx.y, b = row / S, j = threadIdx.x;
    qs[j] = q[(size_t)row * D + h * XD + j]; qs[j + 256] = q[(size_t)row * D + h * XD + 256 + j];
    __syncthreads();
    const float* kr = kk + (size_t)(b * MEM + j) * D + h * XD; float sc = 0.f;
    for (int d = 0; d < XD; ++d) sc += qs[d] * kr[d];
    sc *= 0.044194173824159216f;
    float mx = sc; for (int o2 = 32; o2 > 0; o2 >>= 1) mx = fmaxf(mx, __shfl_xor(mx, o2));
    if ((j & 63) == 0) red[j >> 6] = mx; __syncthreads();
    mx = fmaxf(fmaxf(red[0], red[1]), fmaxf(red[2], red[3])); __syncthreads();
    const float e = expf(sc - mx); float sm = e; for (int o2 = 32; o2 > 0; o2 >>= 1) sm += __shfl_xor(sm, o2);
    if ((j & 63) == 0) red[j >> 6] = sm; __syncthreads();
    sm = red[0] + red[1] + red[2] + red[3];
    p[j] = e / sm; __syncthreads();
    for (int d = j; d < XD; d += 256) { float acc = 0.f; for (int m = 0; m < MEM; ++m) acc += p[m] * vv[(size_t)(b * MEM + m) * D + h * XD + d]; o[(size_t)row * D + h * XD + d] = acc; }
}
}
__global__ void k_bf2f(const unsigned short* in, float* out, size_t n) { size_t i = (size_t)blockIdx.x * 256 + threadIdx.x; if (i < n) out[i] = __builtin_bit_cast(float, (unsigned)in[i] << 16); }
__global__ void k_bf2f_t(const unsigned short* in, float* out, int R, int C) {
    size_t i = (size_t)blockIdx.x * 256 + threadIdx.x; if (i < (size_t)R * C) { const int r = i / C, c = i % C; out[(size_t)c * R + r] = __builtin_bit_cast(float, (unsigned)in[i] << 16); } }
__global__ void k_bf2f_cols(const unsigned short* in, float* out, int R, int C, int c0, int c1) {
    size_t i = (size_t)blockIdx.x * 256 + threadIdx.x; const int w = c1 - c0; if (i < (size_t)R * w) { const int r = i / w, c = c0 + i % w; out[(size_t)r * C + c] = __builtin_bit_cast(float, (unsigned)in[(size_t)r * C + c] << 16); } }
#ifndef DBG_MODE
#define DBG_MODE 7
#endif
static void naive_from(void* const* d_in, void* d_out, void* d_ws, hipStream_t stream, int from) {
    using nv::k_rmsnorm; using nv::k_gemm; using nv::k_gmlp; using nv::k_pool; using nv::k_conv; using nv::k_attn;
    const float* mem = (const float*)d_in[1];
    const float *n_mix_pre = (const float*)d_in[2], *n_mix_post = (const float*)d_in[3], *w_in = (const float*)d_in[4], *w_out = (const float*)d_in[5], *g_v = (const float*)d_in[6],
                *w_sp = (const float*)d_in[7], *b_sp = (const float*)d_in[8], *w_pool = (const float*)d_in[9], *s_pool = (const float*)d_in[10], *w_dw = (const float*)d_in[11], *b_dw = (const float*)d_in[12],
                *cln_g = (const float*)d_in[13], *cln_b = (const float*)d_in[14], *n_xa_pre = (const float*)d_in[15], *n_mem = (const float*)d_in[16], *n_xa_post = (const float*)d_in[17],
                *w_q = (const float*)d_in[18], *w_k = (const float*)d_in[19], *w_v = (const float*)d_in[20], *w_o = (const float*)d_in[21], *n_ffn_pre = (const float*)d_in[22], *n_ffn_post = (const float*)d_in[23],
                *w_up = (const float*)d_in[24], *w_down = (const float*)d_in[25];
    float* xr = (float*)d_out;
    const size_t MD = (size_t)nv::M * nv::D;
    float* ws = (float*)d_ws;
    float* hn = ws; float* hb = hn + MD; float* mn = hb + MD; float* kk = mn + (size_t)nv::MM * nv::D; float* vv = kk + (size_t)nv::MM * nv::D; float* big = vv + (size_t)nv::MM * nv::D;
    float* z = big; float* y = big + (size_t)nv::M * nv::NIN; float* q = big; float* o = big + MD; float* up = big;
    const unsigned char* mws = (const unsigned char*)d_ws;
    if (DBG_MODE == 1 || DBG_MODE == 2 || (DBG_MODE >= 5 && DBG_MODE <= 7)) {
        const int l = 0;
        if (DBG_MODE != 2) {
            k_bf2f<<<(unsigned)(((size_t)nv::M * nv::NIN + 255) / 256), 256, 0, stream>>>((const unsigned short*)(mws + WS_BIG + BO_Z), z, (size_t)nv::M * nv::NIN);
            k_gmlp<<<dim3(nv::M / nv::CH, nv::GH), 256, 0, stream>>>(z, g_v + l * nv::GH * nv::HD, w_sp + (size_t)l * nv::GH * nv::CH * nv::CH, b_sp + l * nv::GH * nv::CH, y);
            k_pool<<<dim3(nv::M / 64, nv::PG), 256, 0, stream>>>(z, w_pool + (size_t)l * nv::PG * 128 * 128, s_pool + l * nv::PW, y);
            k_conv<<<nv::M, 512, 0, stream>>>(z, w_dw + (size_t)l * nv::CK * nv::CW, b_dw + l * nv::CW, cln_g + l * nv::CW, cln_b + l * nv::CW, y);
            if (DBG_MODE >= 5) { const int c0 = DBG_MODE == 5 ? 0 : (DBG_MODE == 6 ? 1024 : 1536), c1 = DBG_MODE == 5 ? 1024 : (DBG_MODE == 6 ? 1536 : 2048);
                k_bf2f_cols<<<(unsigned)(((size_t)nv::M * (c1 - c0) + 255) / 256), 256, 0, stream>>>((const unsigned short*)(mws + WS_BIG + BO_Y), y, nv::M, nv::D, c0, c1); }
        } else {
            k_bf2f<<<(unsigned)((MD + 255) / 256), 256, 0, stream>>>((const unsigned short*)(mws + WS_BIG + BO_Y), y, MD);
        }
        k_gemm<0><<<dim3(nv::D / 64, nv::M / 64), 256, 0, stream>>>(y, w_out + (size_t)l * nv::D * nv::D, hb, nv::M, nv::D, nv::D, 0);
        k_rmsnorm<1><<<nv::M, 256, 0, stream>>>(hb, n_mix_post + l * nv::D, xr, nv::D);
    }
    if (DBG_MODE == 3 || DBG_MODE == 4) {
        const int l = 0;
        if (DBG_MODE == 3) {
            k_bf2f<<<(unsigned)((MD + 255) / 256), 256, 0, stream>>>((const unsigned short*)(mws + WS_BIG + BO_Q), q, MD);
            k_bf2f<<<(unsigned)(((size_t)nv::MM * nv::D + 255) / 256), 256, 0, stream>>>((const unsigned short*)(mws + WS_KB), kk, (size_t)nv::MM * nv::D);
            k_bf2f_t<<<(unsigned)(((size_t)nv::MM * nv::D + 255) / 256), 256, 0, stream>>>((const unsigned short*)(mws + WS_VT), vv, nv::D, nv::MM);
            k_attn<<<dim3(nv::M, nv::XH), 256, 0, stream>>>(q, kk, vv, o);
        } else {
            k_bf2f<<<(unsigned)((MD + 255) / 256), 256, 0, stream>>>((const unsigned short*)(mws + WS_BIG + BO_O), o, MD);
        }
        k_gemm<0><<<dim3(nv::D / 64, nv::M / 64), 256, 0, stream>>>(o, w_o + (size_t)l * nv::D * nv::D, hb, nv::M, nv::D, nv::D, 0);
        k_rmsnorm<1><<<nv::M, 256, 0, stream>>>(hb, n_xa_post + l * nv::D, xr, nv::D);
    }
    for (int sl = from; sl < 6; ++sl) {
        const int l = sl / 3, k = sl % 3;
        if (k == 0) {
            k_rmsnorm<0><<<nv::M, 256, 0, stream>>>(xr, n_mix_pre + l * nv::D, hn, nv::D);
            k_gemm<1><<<dim3(nv::NIN / 64, nv::M / 64), 256, 0, stream>>>(hn, w_in + (size_t)l * nv::D * nv::NIN, z, nv::M, nv::NIN, nv::D, 2 * nv::GW);
            k_gmlp<<<dim3(nv::M / nv::CH, nv::GH), 256, 0, stream>>>(z, g_v + l * nv::GH * nv::HD, w_sp + (size_t)l * nv::GH * nv::CH * nv::CH, b_sp + l * nv::GH * nv::CH, y);
            k_pool<<<dim3(nv::M / 64, nv::PG), 256, 0, stream>>>(z, w_pool + (size_t)l * nv::PG * 128 * 128, s_pool + l * nv::PW, y);
            k_conv<<<nv::M, 512, 0, stream>>>(z, w_dw + (size_t)l * nv::CK * nv::CW, b_dw + l * nv::CW, cln_g + l * nv::CW, cln_b + l * nv::CW, y);
            k_gemm<0><<<dim3(nv::D / 64, nv::M / 64), 256, 0, stream>>>(y, w_out + (size_t)l * nv::D * nv::D, hb, nv::M, nv::D, nv::D, 0);
            k_rmsnorm<1><<<nv::M, 256, 0, stream>>>(hb, n_mix_post + l * nv::D, xr, nv::D);
        } else if (k == 1) {
            k_rmsnorm<0><<<nv::M, 256, 0, stream>>>(xr, n_xa_pre + l * nv::D, hn, nv::D);
            k_rmsnorm<0><<<nv::MM, 256, 0, stream>>>(mem, n_mem + l * nv::D, mn, nv::D);
            k_gemm<0><<<dim3(nv::D / 64, nv::M / 64), 256, 0, stream>>>(hn, w_q + (size_t)l * nv::D * nv::D, q, nv::M, nv::D, nv::D, 0);
            k_gemm<0><<<dim3(nv::D / 64, nv::MM / 64), 256, 0, stream>>>(mn, w_k + (size_t)l * nv::D * nv::D, kk, nv::MM, nv::D, nv::D, 0);
            k_gemm<0><<<dim3(nv::D / 64, nv::MM / 64), 256, 0, stream>>>(mn, w_v + (size_t)l * nv::D * nv::D, vv, nv::MM, nv::D, nv::D, 0);
            k_attn<<<dim3(nv::M, nv::XH), 256, 0, stream>>>(q, kk, vv, o);
            k_gemm<0><<<dim3(nv::D / 64, nv::M / 64), 256, 0, stream>>>(o, w_o + (size_t)l * nv::D * nv::D, hb, nv::M, nv::D, nv::D, 0);
            k_rmsnorm<1><<<nv::M, 256, 0, stream>>>(hb, n_xa_post + l * nv::D, xr, nv::D);
        } else {
            k_rmsnorm<0><<<nv::M, 256, 0, stream>>>(xr, n_ffn_pre + l * nv::D, hn, nv::D);
            k_gemm<2><<<dim3(nv::FF / 64, nv::M / 64), 256, 0, stream>>>(hn, w_up + (size_t)l * nv::D * nv::FF, up, nv::M, nv::FF, nv::D, 0);
            k_gemm<0><<<dim3(nv::D / 64, nv::M / 64), 256, 0, stream>>>(up, w_down + (size_t)l * nv::FF * nv::D, hb, nv::M, nv::D, nv::FF, 0);
            k_rmsnorm<1><<<nv::M, 256, 0, stream>>>(hb, n_ffn_post + l * nv::D, xr, nv::D);
        }
    }
}
#endif

extern "C" void kernel_launch(void* const* d_in, const int* in_sizes, int n_in, void* d_out, int out_size, void* d_ws, size_t ws_size, hipStream_t stream) {
    static int grid = 0;
    if (grid == 0) {
        if (n_in != 26 || in_sizes[0] != M * D || out_size != M * D || ws_size < WS_END) { fprintf(stderr, "kernel_launch: unexpected shapes (n_in %d, in0 %d, out %d, ws %zu < %zu); nothing launched\n", n_in, n_in > 0 ? in_sizes[0] : -1, out_size, ws_size, (size_t)WS_END); grid = -1; return; }
        int dev = 0, cus = 0, per_cu = 0;
        if (hipGetDevice(&dev) != hipSuccess || hipDeviceGetAttribute(&cus, hipDeviceAttributeMultiprocessorCount, dev) != hipSuccess) { grid = -1; return; }
        if (hipFuncSetAttribute((const void*)mega_fwd, hipFuncAttributeMaxDynamicSharedMemorySize, LDS_BYTES) != hipSuccess) { fprintf(stderr, "kernel_launch: hipFuncSetAttribute failed\n"); grid = -1; return; }
        if (hipOccupancyMaxActiveBlocksPerMultiprocessor(&per_cu, (const void*)mega_fwd, NWAVES * 64, LDS_BYTES) != hipSuccess || per_cu < 1) { fprintf(stderr, "kernel_launch: occupancy query says %d blocks per CU\n", per_cu); per_cu = 1; }
        (void)hipGetLastError();
        grid = cus * 1;
    }
    if (grid < 0) return;
    if (hipMemsetAsync((char*)d_ws + WS_CTL, 0, CTL_ZERO_BYTES, stream) != hipSuccess) { fprintf(stderr, "kernel_launch: memset failed\n"); return; }
    Args a{};
    for (int i = 0; i < 26; ++i) a.in[i] = (const float*)d_in[i];
    a.out = (float*)d_out; a.ws = (unsigned char*)d_ws;
    a.rep = PROBE_REP;
    { const int stops[7] = {1, 5, 8, 11, 15, 18, 1000}; a.stop = stops[DBG_CUT]; }
#if DBG_CUT < 6
    if (DBG_MODE == 1) a.stop = 2; if (DBG_MODE == 2 || DBG_MODE >= 5) a.stop = 3; if (DBG_MODE == 3) a.stop = 6; if (DBG_MODE == 4) a.stop = 8;
#endif
    void* kargs[] = {&a};
    hipError_t e = hipLaunchCooperativeKernel((const void*)mega_fwd, dim3(grid), dim3(NWAVES * 64), kargs, LDS_BYTES, stream);
    if (e != hipSuccess) fprintf(stderr, "kernel_launch: cooperative launch failed: %s (grid %d)\n", hipGetErrorString(e), grid);
#if DBG_CUT < 6
    naive_from(d_in, d_out, d_ws, stream, DBG_CUT);
#endif
}
```

```cpp
#include <hip/hip_runtime.h>
#include <cstdio>
#include <cstdint>

#define LAS __attribute__((address_space(3)))
#define GAS __attribute__((address_space(1)))
typedef unsigned short bf16_t;
typedef short bf16x8 __attribute__((ext_vector_type(8)));
typedef float f32x4 __attribute__((ext_vector_type(4)));
typedef float f32x2 __attribute__((ext_vector_type(2)));
typedef unsigned u32x4 __attribute__((ext_vector_type(4)));
typedef unsigned u32x2 __attribute__((ext_vector_type(2)));

constexpr int D = 2048, NB = 4, SEQ = 2048, NL = 2, MEM = 256, GW = 1024, PW = 512, CW = 512, NIN = 3584, GH = 8, HD = 128, CH = 128, PG = 4, CK = 31, XH = 4, XD = 512, FF = 8192;
constexpr int M = NB * SEQ, MM = NB * MEM;
constexpr float RMS_EPS = 1e-6f, LN_EPS = 1e-5f;

constexpr size_t MiB = 1u << 20;
constexpr size_t WS_CTL = 0, CTL_ZERO_BYTES = 32 * 1024; constexpr int CW_XCC = 7680;
constexpr size_t WS_WPT = 1 * MiB, WS_WSM = 1 * MiB + 256 * 1024;
constexpr size_t WS_W = 2 * MiB, W_LAYER = 118 * MiB;
constexpr size_t WO_IN = 0, WO_OUT = 14 * MiB, WO_Q = 22 * MiB, WO_KV = 30 * MiB, WO_O = 46 * MiB, WO_UP = 54 * MiB, WO_DN = 86 * MiB;
constexpr size_t WS_MN = 238 * MiB;
constexpr size_t WS_KB = 246 * MiB, WS_VB = 250 * MiB, WS_VT = WS_VB;
constexpr size_t WS_XN = 254 * MiB;
constexpr size_t WS_HB = 286 * MiB;
constexpr size_t WS_BIG = 350 * MiB;
constexpr size_t BO_Z = 0, BO_Y = 56 * MiB, BO_Q = 0, BO_P = 32 * MiB, BO_O = 64 * MiB, BO_UP = 0;
constexpr size_t BO_GT = 0, BO_UT = 16 * MiB;
constexpr size_t WS_XH = 478 * MiB;
constexpr size_t WS_END = 510 * MiB;
constexpr int CW_BAR = 4096;

constexpr int RING_BYTES = 131072, LDSCTL_OFF = RING_BYTES, MISC_OFF = LDSCTL_OFF + 320, LDS_BYTES = 147456;
constexpr int NWAVES = 8;

#define LDS_WAIT() asm volatile("s_waitcnt lgkmcnt(0)" ::: "memory")
#define VM_WAIT() asm volatile("s_waitcnt vmcnt(0)" ::: "memory")
#define RLX_AGENT __ATOMIC_RELAXED, __HIP_MEMORY_SCOPE_AGENT

__device__ __forceinline__ unsigned cvt_pk_bf16(float lo, float hi) { unsigned r; asm volatile("v_cvt_pk_bf16_f32 %0, %1, %2" : "=v"(r) : "v"(lo), "v"(hi)); return r; }
__device__ __forceinline__ float bf_lo(unsigned w) { return __builtin_bit_cast(float, w << 16); }
__device__ __forceinline__ float bf_hi(unsigned w) { return __builtin_bit_cast(float, w & 0xffff0000u); }
typedef _Float16 f16x2 __attribute__((ext_vector_type(2)));
__device__ __forceinline__ unsigned pk_f16(float a, float b) { f16x2 v; v[0] = (_Float16)a; v[1] = (_Float16)b; return __builtin_bit_cast(unsigned, v); }
__device__ __forceinline__ f32x2 unpk_f16(unsigned w) { const f16x2 v = __builtin_bit_cast(f16x2, w); const _Float16 a = v[0], b = v[1]; return (f32x2){(float)a, (float)b}; }
__device__ __forceinline__ float fast_sigmoid(float x) { return __builtin_amdgcn_rcpf(1.f + __builtin_amdgcn_exp2f(-1.44269504089f * x)); }
__device__ __forceinline__ float gelu_tanh(float x) { const float u = 0.7978845608028654f * (x + 0.044715f * x * x * x); return x * fast_sigmoid(2.f * u); }
__device__ __forceinline__ int opaque_s(int v) { asm volatile("" : "+s"(v)); return v; }
__device__ __forceinline__ int fresh_tid() { int t = threadIdx.x; asm volatile("" : "+v"(t)); return t; }
template <int CTRL> __device__ __forceinline__ float dppf(float v) { return __builtin_bit_cast(float, __builtin_amdgcn_update_dpp(0, __builtin_bit_cast(int, v), CTRL, 0xf, 0xf, true)); }
__device__ __forceinline__ float lx1(float v) { return dppf<0xB1>(v); }
__device__ __forceinline__ float lx2(float v) { return dppf<0x4E>(v); }
__device__ __forceinline__ float lx16(float v) { return __builtin_bit_cast(float, __builtin_amdgcn_ds_swizzle(__builtin_bit_cast(int, v), 0x401F)); }
__device__ __forceinline__ void halves32(float v, float& lo, float& hi) {
    const unsigned u = __builtin_bit_cast(unsigned, v); auto r = __builtin_amdgcn_permlane32_swap(u, u, false, false);
    const unsigned r0 = r[0], r1 = r[1];
    lo = __builtin_bit_cast(float, r0); hi = __builtin_bit_cast(float, r1); }
__device__ __forceinline__ float sum_x32(float v) { float a, b; halves32(v, a, b); return a + b; }
__device__ __forceinline__ float max_x32(float v) { float a, b; halves32(v, a, b); return fmaxf(a, b); }
__device__ __forceinline__ float wave_sum(float v) {
    v += lx1(v); v += lx2(v); v += dppf<0x141>(v)  ; v += dppf<0x140>(v)  ; v += lx16(v); return sum_x32(v);
}

#define XB_TMO      128
#define XB_XCNT(j)  (256  + 64 * (j))
#define XB_XSUB(j)  (1280 + 64 * (j))
#define XB_XGEN(j)  (2304 + 64 * (j))
#define XB_TOP      3328
#define XB_TOPGEN   3392
#define XCD_BAR_WORDS 3456
#define XB_SPIN_CAP (1u << 18)
__device__ __forceinline__ unsigned xb_ld(unsigned* p)              { return __hip_atomic_load(p, __ATOMIC_RELAXED, __HIP_MEMORY_SCOPE_AGENT); }
__device__ __forceinline__ unsigned xb_add(unsigned* p, unsigned v) { return __hip_atomic_fetch_add(p, v, __ATOMIC_RELAXED, __HIP_MEMORY_SCOPE_AGENT); }
__device__ __forceinline__ unsigned xb_xcc_id() { return (unsigned)__builtin_amdgcn_s_getreg((3 << 11) | 20) & 0xFu; }
#define XB_SPIN(cond, bar) do { unsigned _sp = 0; while (cond) { __builtin_amdgcn_s_sleep(1); \
    if ((++_sp & 255u) == 0u) { if (xb_ld(&(bar)[XB_TMO])) break; if (_sp > XB_SPIN_CAP) { atomicAdd(&(bar)[XB_TMO], 1u); break; } } } } while (0)
struct XcdBarrier { unsigned* bar; unsigned x; volatile LAS unsigned* st; };
__device__ __forceinline__ XcdBarrier xcd_barrier_post(unsigned* bar, volatile LAS unsigned* st) {
    XcdBarrier b; b.bar = bar; b.x = xb_xcc_id(); b.st = st;
    if (threadIdx.x == 0) (void)xb_add(&bar[XB_XCNT(b.x)], 1u);
    return b;
}
__device__ __forceinline__ void xcd_barrier_complete(unsigned* bar, unsigned x, unsigned& nloc, unsigned& nx) {
    const unsigned G = gridDim.x * gridDim.y * gridDim.z;
    unsigned sum, cnt, mine, sp = 0u;
    for (;;) {
        sum = 0u; cnt = 0u; mine = 0u;
#pragma unroll
        for (unsigned j = 0; j < 16; ++j) { const unsigned c = xb_ld(&bar[XB_XCNT(j)]); sum += c; cnt += (c > 0u) ? 1u : 0u; mine = (j == x) ? c : mine; }
        if (sum == G) break;
        __builtin_amdgcn_s_sleep(1);
        if ((++sp & 255u) == 0u) { if (xb_ld(&bar[XB_TMO])) break; if (sp > XB_SPIN_CAP) { atomicAdd(&bar[XB_TMO], 1u); break; } }
    }
    nloc = mine > 0u ? mine : 1u; nx = cnt > 0u ? cnt : 1u;
}
__device__ __forceinline__ void xcd_barrier(const XcdBarrier& b, bool no_wb = false) {
    asm volatile("s_waitcnt vmcnt(0)" ::: "memory");
    __syncthreads();
    if (threadIdx.x == 0) {
        unsigned* bar = b.bar; asm volatile("" : "+s"(bar));
        __builtin_amdgcn_s_waitcnt(0);
        unsigned nloc = b.st[0], nx = b.st[1]; unsigned bx = b.x; asm volatile("" : "+s"(bx));
        if (nloc == 0u) { xcd_barrier_complete(bar, bx, nloc, nx); b.st[0] = nloc; b.st[1] = nx; }
        const unsigned old = xb_add(&bar[XB_XSUB(bx)], 1u);
        const unsigned gen = old / nloc;
        if (old + 1u == (gen + 1u) * nloc) {
            if (!no_wb) __builtin_amdgcn_fence(__ATOMIC_RELEASE, "agent");
            asm volatile("s_waitcnt vmcnt(0)" ::: "memory");
            const unsigned og = xb_add(&bar[XB_TOP], 1u);
            const unsigned tg = og / nx;
            if (og + 1u == (tg + 1u) * nx) xb_add(&bar[XB_TOPGEN], 1u);
            else XB_SPIN(xb_ld(&bar[XB_TOPGEN]) == tg, bar);
            __builtin_amdgcn_fence(__ATOMIC_ACQUIRE, "agent");
            xb_add(&bar[XB_XGEN(bx)], 1u);
            asm volatile("s_waitcnt vmcnt(0)" ::: "memory");
        } else {
            XB_SPIN(xb_ld(&bar[XB_XGEN(bx)]) == gen, bar);
            __builtin_amdgcn_fence(__ATOMIC_ACQUIRE, "agent");
            asm volatile("s_waitcnt vmcnt(0)" ::: "memory");
        }
    }
    __syncthreads();
}

namespace pg8 {
constexpr int BM = 256, BK = 64, HALF = 128, HTB = HALF * BK * 2, STAGE_BYTES = 8 * HTB, NXCD = 8, WGM = 8;
__host__ __device__ __forceinline__ int lds_byte(int r, int c) { const int st = (r >> 4) * 2 + (c >> 5), rr = r & 15, cc = c & 31, ob = rr * 64 + cc * 2; return st * 1024 + (ob ^ (((ob >> 9) & 1) << 5)); }
__host__ __device__ __forceinline__ void stage_rc(int b, int& R, int& C) { const int st = b / 1024, sb = b % 1024, swz = sb ^ (((sb >> 9) & 1) << 5); R = (st >> 1) * 16 + swz / 64; C = (st & 1) * 32 + (swz % 64) / 2; }
__host__ __device__ __forceinline__ int perm32(int rho) { const int n = rho >> 4, i = rho & 15; return 8 * (i >> 2) + 4 * n + (i & 3); }

struct Unit { const char* A; const char* B; void* O; int ldo, pm, pn, flag, nt; };

__device__ __forceinline__ void tile_order(int L, int nM, int nN, int& pm, int& pn) {
    const int nwg = nM * nN; int wgid = L; { const int q = nwg / NXCD, r = nwg % NXCD, xcd = wgid % NXCD, off = wgid / NXCD; wgid = (xcd < r ? xcd * (q + 1) : r * (q + 1) + (xcd - r) * q) + off; }
    const int nig = WGM * nN, gid = wgid / nig, fm = gid * WGM, gsz = (nM - fm) < WGM ? (nM - fm) : WGM;
    pm = fm + ((wgid % nig) % gsz); pn = (wgid % nig) / gsz;
}

struct EpiF32 {
    static constexpr bool PERM = false, AFTER_DRAIN = false;
    __device__ __forceinline__ void operator()(const f32x4 (&acc)[2][2][4][2], const Unit& u, int wr, int wc, int fr, int fq) const {
        { const int t_ = fresh_tid(); fr = t_ & 15; fq = (t_ >> 4) & 3; }
        const int row0 = u.pm * BM + wr * 64 + fr, col0 = u.pn * BM + wc * 32 + 4 * fq; float* C = (float*)u.O;
#pragma unroll
        for (int ai = 0; ai < 2; ++ai)
#pragma unroll
            for (int m = 0; m < 4; ++m) { float* rowp = C + (size_t)(row0 + ai * HALF + m * 16) * u.ldo + col0;
#pragma unroll
                for (int bj = 0; bj < 2; ++bj)
#pragma unroll
                    for (int n = 0; n < 2; ++n) *(f32x4*)(rowp + bj * HALF + n * 16) = acc[ai][bj][m][n]; }
    }
};
template <int ACT> struct EpiBf16 {
    static constexpr bool PERM = true, AFTER_DRAIN = false;
    __device__ __forceinline__ void operator()(const f32x4 (&acc)[2][2][4][2], const Unit& u, int wr, int wc, int fr, int fq) const {
        { const int t_ = fresh_tid(); fr = t_ & 15; fq = (t_ >> 4) & 3; }
        const int row0 = u.pm * BM + wr * 64 + fr, col0 = u.pn * BM + wc * 32 + 8 * fq; bf16_t* base = (bf16_t*)u.O;
        const bool act1 = (ACT == 1) && (u.flag != 0);
#pragma unroll
        for (int ai = 0; ai < 2; ++ai)
#pragma unroll
            for (int m = 0; m < 4; ++m) { bf16_t* rowp = base + (size_t)(row0 + ai * HALF + m * 16) * u.ldo + col0;
#pragma unroll
                for (int bj = 0; bj < 2; ++bj) { f32x4 v0 = acc[ai][bj][m][0], v1 = acc[ai][bj][m][1];
                    if (ACT == 1) { if (act1) {
#pragma unroll
                        for (int e = 0; e < 4; ++e) { v0[e] = gelu_tanh(v0[e]); v1[e] = gelu_tanh(v1[e]); } } }
                    if (ACT == 2) {
#pragma unroll
                        for (int e = 0; e < 4; ++e) { const float a = fmaxf(v0[e], 0.f), b = fmaxf(v1[e], 0.f); v0[e] = a * a; v1[e] = b * b; } }
                    u32x4 w; w.x = cvt_pk_bf16(v0[0], v0[1]); w.y = cvt_pk_bf16(v0[2], v0[3]); w.z = cvt_pk_bf16(v1[0], v1[1]); w.w = cvt_pk_bf16(v1[2], v1[3]);
                    *(u32x4*)(rowp + bj * HALF) = w; } }
    }
};
struct EpiSoftmax {
    static constexpr bool PERM = true, AFTER_DRAIN = true;
    float scale_log2e;
    __device__ __forceinline__ void fused(f32x4 (&acc)[2][2][4][2], const Unit& u, int wr, int wc, int fr, int fq, LAS unsigned char* lds, int wid, int lane) const {
        LAS f32x2* P = (LAS f32x2*)lds;
#pragma unroll
        for (int ai = 0; ai < 2; ++ai)
#pragma unroll
            for (int m = 0; m < 4; ++m) {
                float mx = -3.0e38f;
#pragma unroll
                for (int bj = 0; bj < 2; ++bj)
#pragma unroll
                    for (int n = 0; n < 2; ++n) { const f32x4 x = acc[ai][bj][m][n]; mx = fmaxf(mx, fmaxf(fmaxf(x[0], x[1]), fmaxf(x[2], x[3]))); }
                mx = fmaxf(mx, lx16(mx)); mx = max_x32(mx);
                float s = 0.f;
#pragma unroll
                for (int bj = 0; bj < 2; ++bj)
#pragma unroll
                    for (int n = 0; n < 2; ++n) { f32x4 x = acc[ai][bj][m][n];
#pragma unroll
                        for (int e = 0; e < 4; ++e) { x[e] = __builtin_amdgcn_exp2f((x[e] - mx) * scale_log2e); s += x[e]; }
                        acc[ai][bj][m][n] = x; }
                s += lx16(s); s = sum_x32(s);
                if (fq == 0) P[(ai * HALF + wr * 64 + m * 16 + fr) * 4 + wc] = (f32x2){mx, s};
            }
        asm volatile("s_waitcnt lgkmcnt(0)" ::: "memory"); __builtin_amdgcn_s_barrier(); asm volatile("" ::: "memory");
        const int row0 = u.pm * BM + wr * 64 + fr, col0 = u.pn * BM + wc * 32 + 8 * fq; bf16_t* base = (bf16_t*)u.O;
#pragma unroll
        for (int ai = 0; ai < 2; ++ai)
#pragma unroll
            for (int m = 0; m < 4; ++m) {
                const int r = ai * HALF + wr * 64 + m * 16 + fr;
                const f32x2 a = P[r * 4 + 0], b = P[r * 4 + 1], c = P[r * 4 + 2], d = P[r * 4 + 3];
                const float mt = fmaxf(fmaxf(a.x, b.x), fmaxf(c.x, d.x));
                const float ea = __builtin_amdgcn_exp2f((a.x - mt) * scale_log2e), eb = __builtin_amdgcn_exp2f((b.x - mt) * scale_log2e), ec = __builtin_amdgcn_exp2f((c.x - mt) * scale_log2e), ed = __builtin_amdgcn_exp2f((d.x - mt) * scale_log2e);
                const float tot = a.y * ea + b.y * eb + c.y * ec + d.y * ed;
                const float mine = (wc == 0 ? ea : wc == 1 ? eb : wc == 2 ? ec : ed) / tot;
                bf16_t* rowp = base + (size_t)(row0 + ai * HALF + m * 16) * u.ldo + col0;
#pragma unroll
                for (int bj = 0; bj < 2; ++bj) { const f32x4 v0 = acc[ai][bj][m][0] * mine, v1 = acc[ai][bj][m][1] * mine;
                    u32x4 w; w.x = cvt_pk_bf16(v0[0], v0[1]); w.y = cvt_pk_bf16(v0[2], v0[3]); w.z = cvt_pk_bf16(v1[0], v1[1]); w.w = cvt_pk_bf16(v1[2], v1[3]);
                    *(u32x4*)(rowp + bj * HALF) = w; }
            }
    }
};

template <class Epi, class Sched>
__device__ __forceinline__ void gemm_phase(LAS unsigned char* lds, const int lda, const int ldb, const Sched& S, const Epi& E) {
    const int tid = fresh_tid(), wid = __builtin_amdgcn_readfirstlane(tid >> 6), lane = tid & 63, wr = wid >> 2, wc = wid & 3, fr = lane & 15, fq = lane >> 4;
    unsigned voffA[2], voffB[2];
#pragma unroll
    for (int i = 0; i < 2; ++i) { int R, C; stage_rc(tid * 16 + i * 8192, R, C); const int Rb = Epi::PERM ? ((R & ~31) + perm32(R & 31)) : R;
        voffA[i] = (unsigned)(R * lda + C) * 2u; voffB[i] = (unsigned)(Rb * ldb + C) * 2u; }
    const size_t kstep = (size_t)(BK * 2);
    const size_t hstepA = (size_t)HALF * lda * 2, hstepB = (size_t)HALF * ldb * 2;
    const unsigned ldsw = (unsigned)wid * 1024u;
    const int aoff = lds_byte(wr * 64 + fr, fq * 8), boff = lds_byte(wc * 32 + fr, fq * 8);
#define PG8_SA(b, h) (((b) * 2 + (h)) * HTB)
#define PG8_SB(b, h) ((4 + (b) * 2 + (h)) * HTB)
#define PG8_STAGE(bufoff, gbase, voff) do { _Pragma("unroll") for (int _i = 0; _i < 2; ++_i) \
        __builtin_amdgcn_global_load_lds((const unsigned*)((const char*)(gbase) + (voff)[_i]), (LAS unsigned*)(lds + (bufoff) + ldsw + _i * 8192), 16, 0, 0); } while (0)
#define PG8_LDA(dst, b, h) do { _Pragma("unroll") for (int m = 0; m < 4; ++m) _Pragma("unroll") for (int k = 0; k < 2; ++k) dst[m][k] = *(const LAS bf16x8*)(lds + PG8_SA(b, h) + aoff + m * 2048 + k * 1024); } while (0)
#define PG8_LDB(dst, b, h) do { _Pragma("unroll") for (int n = 0; n < 2; ++n) _Pragma("unroll") for (int k = 0; k < 2; ++k) dst[n][k] = *(const LAS bf16x8*)(lds + PG8_SB(b, h) + boff + n * 2048 + k * 1024); } while (0)
#define PG8_MMA(ai, bj, At, Bt) do { __builtin_amdgcn_s_setprio(1); _Pragma("unroll") for (int m = 0; m < 4; ++m) _Pragma("unroll") for (int n = 0; n < 2; ++n) _Pragma("unroll") for (int k = 0; k < 2; ++k) \
        acc[ai][bj][m][n] = __builtin_amdgcn_mfma_f32_16x16x32_bf16(Bt[n][k], At[m][k], acc[ai][bj][m][n], 0, 0, 0); __builtin_amdgcn_s_setprio(0); } while (0)
#define PG8_WAIT_V(n) asm volatile("s_waitcnt vmcnt(" #n ")" ::: "memory")
#define PG8_WAIT_L(n) asm volatile("s_waitcnt lgkmcnt(" #n ")" ::: "memory")
#define PG8_BAR __builtin_amdgcn_s_barrier()
#define PG8_SCHED __builtin_amdgcn_sched_barrier(0)
    Unit cur, nxt; int ui = 0;
    if (!S.next(0, cur)) return;
    f32x4 acc[2][2][4][2];
#pragma unroll
    for (int a = 0; a < 2; ++a)
#pragma unroll
        for (int b = 0; b < 2; ++b)
#pragma unroll
            for (int m = 0; m < 4; ++m)
#pragma unroll
                for (int n = 0; n < 2; ++n) acc[a][b][m][n] = (f32x4){0.f, 0.f, 0.f, 0.f};
    bf16x8 At[4][2], B0[2][2], B1[2][2];
    const char* cA = cur.A; const char* cB = cur.B;
    PG8_STAGE(PG8_SB(0, 0), cB, voffB); PG8_STAGE(PG8_SB(0, 1), cB + hstepB, voffB); PG8_STAGE(PG8_SA(0, 0), cA, voffA); PG8_STAGE(PG8_SA(0, 1), cA + hstepA, voffA);
    if (wr == 1) PG8_BAR;
    PG8_WAIT_V(2); PG8_BAR;
    PG8_STAGE(PG8_SB(1, 0), cB + kstep, voffB); PG8_STAGE(PG8_SA(1, 0), cA + kstep, voffA); PG8_STAGE(PG8_SB(1, 1), cB + hstepB + kstep, voffB);
    PG8_WAIT_V(6); PG8_BAR;
    for (;;) {
        const bool has_next = S.next(ui + 1, nxt);
        const char* nA = has_next ? nxt.A : cA; const char* nB = has_next ? nxt.B : cB;
        const int nt = cur.nt;
        for (int t = 0; t < nt; t += 2) {
            const bool last = (t == nt - 2);
            const char* a1 = cA + (size_t)(t + 1) * kstep;
            const char* a2 = last ? nA : cA + (size_t)(t + 2) * kstep; const char* b2 = last ? nB : cB + (size_t)(t + 2) * kstep;
            const char* a3 = a2 + kstep; const char* b3 = b2 + kstep;
            PG8_LDB(B0, 0, 0); PG8_LDB(B1, 0, 1); PG8_SCHED; PG8_LDA(At, 0, 0); PG8_STAGE(PG8_SA(1, 1), a1 + hstepA, voffA);
            PG8_WAIT_V(8); PG8_WAIT_L(0); PG8_BAR; PG8_MMA(0, 0, At, B0); PG8_MMA(0, 1, At, B1); PG8_BAR; PG8_SCHED;
            PG8_LDA(At, 0, 1); PG8_STAGE(PG8_SB(0, 0), b2, voffB); PG8_STAGE(PG8_SB(0, 1), b2 + hstepB, voffB); PG8_STAGE(PG8_SA(0, 0), a2, voffA);
            PG8_WAIT_V(8); PG8_WAIT_L(0); PG8_BAR; PG8_MMA(1, 0, At, B0); PG8_MMA(1, 1, At, B1); PG8_BAR; PG8_SCHED;
            PG8_LDB(B0, 1, 0); PG8_LDB(B1, 1, 1); PG8_SCHED; PG8_LDA(At, 1, 0); PG8_STAGE(PG8_SA(0, 1), a2 + hstepA, voffA);
            PG8_WAIT_V(8); PG8_WAIT_L(0); PG8_BAR; PG8_MMA(0, 0, At, B0); PG8_MMA(0, 1, At, B1); PG8_BAR; PG8_SCHED;
            PG8_LDA(At, 1, 1); PG8_STAGE(PG8_SB(1, 0), b3, voffB); PG8_STAGE(PG8_SB(1, 1), b3 + hstepB, voffB); PG8_STAGE(PG8_SA(1, 0), a3, voffA);
            PG8_WAIT_V(8); PG8_WAIT_L(0); PG8_BAR; PG8_MMA(1, 0, At, B0); PG8_MMA(1, 1, At, B1); PG8_BAR; PG8_SCHED;
        }
        if (wr == 0) PG8_BAR;
        if constexpr (!Epi::AFTER_DRAIN) { E(acc, cur, wr, wc, fr, fq); }
        if (!has_next) break;
#pragma unroll
        for (int a = 0; a < 2; ++a)
#pragma unroll
            for (int b = 0; b < 2; ++b)
#pragma unroll
                for (int m = 0; m < 4; ++m)
#pragma unroll
                    for (int n = 0; n < 2; ++n) acc[a][b][m][n] = (f32x4){0.f, 0.f, 0.f, 0.f};
        cur = nxt; cA = nA; cB = nB; ++ui;
        if (wr == 1) PG8_BAR;
    }
    PG8_WAIT_V(0);
    PG8_BAR;
    if constexpr (Epi::AFTER_DRAIN) { E.fused(acc, cur, wr, wc, fr, fq, lds, wid, lane); }
#undef PG8_SA
#undef PG8_SB
#undef PG8_STAGE
#undef PG8_LDA
#undef PG8_LDB
#undef PG8_MMA
#undef PG8_WAIT_V
#undef PG8_WAIT_L
#undef PG8_BAR
#undef PG8_SCHED
}
}

template <int LDA, int LDB, int LDO, int NM, int NN, int KD> struct SchedPlain {
    const char* A; const char* B; void* O; int G, c, xg;
    __device__ __forceinline__ bool next(int i, pg8::Unit& u) const {
        int pm, pn;
        if (xg >= 0) { const int Lp = i * 32 + c; if (Lp >= 4 * NN) return false; pm = 4 * xg + (Lp & 3); pn = Lp >> 2; }
        else { const int L = i * G + c; if (L >= NM * NN) return false; pg8::tile_order(L, NM, NN, pm, pn); }
        u.A = A + (size_t)pm * 256 * LDA * 2; u.B = B + (size_t)pn * 256 * LDB * 2; u.O = O; u.ldo = LDO; u.pm = pm; u.pn = pn; u.flag = 0; u.nt = KD / 64; return true;
    }
};
struct SchedIn {
    const char* ws; const char* wl; const char* mn; int G, c, xg;
    __device__ __forceinline__ bool next(int i, pg8::Unit& u) const {
        int pm, pn, Lk; bool isz;
        if (xg >= 0) { const int Lp = i * 32 + c; if (Lp >= 64) return false; isz = Lp < 56; pm = 4 * xg + (Lp & 3); pn = Lp >> 2; Lk = xg * 8 + (Lp - 56); }
        else { const int L = i * G + c; if (L >= 512) return false; isz = L < 448; pg8::tile_order(isz ? L : 0, 32, 14, pm, pn); Lk = L - 448; }
        const bool isk = Lk < 32; const int Lv = Lk - 32;
        const int pmk = Lk & 3, pnk = Lk >> 2, pmv = Lv & 3, pnv = Lv >> 2;
        pm = isz ? pm : (isk ? pmk : pmv); pn = isz ? pn : (isk ? pnk : pnv);
        const char* a0 = isz ? ws + WS_XN : mn;
        const char* b0 = isz ? wl + WO_IN : (isk ? wl + WO_KV : wl + WO_KV + (size_t)D * D * 2);
        u.A = a0 + (size_t)pm * 256 * D * 2; u.B = b0 + (size_t)pn * 256 * D * 2;
        u.O = (void*)(isz ? ws + WS_BIG + BO_Z : (isk ? ws + WS_KB : ws + WS_VB)); u.ldo = isz ? NIN : D;
        u.pm = pm; u.pn = pn; u.flag = isz && pn < 8; u.nt = D / 64; return true;
    }
};
struct SchedGU {
    const char* ws; const char* wl; int G, c, xg;
    __device__ __forceinline__ bool next(int i, pg8::Unit& u) const {
        const int L = (xg >= 0) ? i * 256 + xg * 32 + c : i * G + c;
        if (L < 256) { int pm, pn; if (xg >= 0) { pm = 4 * xg + (c & 3); pn = c >> 2; } else pg8::tile_order(L, M / 256, D / 256, pm, pn);
            u.A = ws + WS_BIG + BO_Y + (size_t)pm * 256 * D * 2; u.B = wl + WO_OUT + (size_t)pn * 256 * D * 2; u.O = (void*)(ws + WS_HB); u.ldo = D; u.pm = pm; u.pn = pn; u.flag = 0; u.nt = D / 64; return true; }
        const int L2 = L - 256; if (L2 >= 256) return false;
        const bool isg = L2 < 128; const int j = L2 & 127, bh = j >> 3, t = j & 7, b = bh >> 2, h = bh & 3;
        const char* kv = ws + (isg ? WS_KB : WS_VB) + ((size_t)(b * MEM) * D + h * XD) * 2;
        const char* w = wl + (isg ? WO_Q : WO_O) + ((size_t)(t * 256) * D + h * XD) * 2;
        u.A = isg ? kv : w; u.B = isg ? w : kv;
        u.O = (void*)(isg ? ws + WS_BIG + BO_GT : ws + WS_BIG + BO_UT + (size_t)b * D * (XH * MEM) * 2);
        u.ldo = isg ? D : XH * MEM; u.pm = isg ? bh : t; u.pn = isg ? t : h; u.flag = 0; u.nt = XD / 64; return true;
    }
};
struct SchedS {
    const char* XN; const char* GT; void* P; int G, c, xg;
    __device__ __forceinline__ bool next(int i, pg8::Unit& u) const {
        int b, h, rp;
        if (xg >= 0) { if (i > 0 || c >= 16) return false; const int pm = 4 * xg + (c & 3); h = c >> 2; b = pm >> 3; rp = pm & 7; }
        else { const int L = i * G + c; if (L >= 128) return false; b = L >> 5; h = (L >> 3) & 3; rp = L & 7; }
        u.A = XN + (size_t)(b * SEQ + rp * 256) * D * 2; u.B = GT + (size_t)((b * 4 + h) * 256) * D * 2; u.O = P; u.ldo = XH * MEM; u.pm = b * 8 + rp; u.pn = h; u.flag = 0; u.nt = D / 64; return true;
    }
};
struct SchedO {
    const char* P; const char* UT; void* HB; int G, c, xg;
    __device__ __forceinline__ bool next(int i, pg8::Unit& u) const {
        int pm, pn;
        if (xg >= 0) { if (i > 0) return false; pm = 4 * xg + (c & 3); pn = c >> 2; }
        else { const int L = i * G + c; if (L >= 256) return false; pg8::tile_order(L, 32, 8, pm, pn); }
        const int b = pm >> 3;
        u.A = P + (size_t)pm * 256 * (XH * MEM) * 2; u.B = UT + ((size_t)b * D + pn * 256) * (XH * MEM) * 2; u.O = HB; u.ldo = D; u.pm = pm; u.pn = pn; u.flag = 0; u.nt = (XH * MEM) / 64; return true;
    }
};

struct Frame {
    LAS unsigned char* lds; int tid, lane, wave, vcu, G; int xg; bool local;
    decltype(__builtin_amdgcn_kernarg_segment_ptr()) kp; float* out; unsigned char* ws;
};
__device__ __forceinline__ const float* inp(const Frame& F, int i) { asm volatile("" : "+s"(i)); return (const float*)*(const GAS float* const*)((const char*)F.kp + 8 * i); }

__device__ __forceinline__ void refresh(Frame& F) { F.tid = fresh_tid(); F.lane = F.tid & 63; F.wave = __builtin_amdgcn_readfirstlane(F.tid >> 6); }
constexpr int T_IN = (D / 64) * (NIN / 64), T_SQ = (D / 64) * (D / 64), T_UP = (D / 64) * (FF / 64);
constexpr int T_TR = T_IN + 4 * T_SQ + 2 * T_UP;
constexpr int U_LAYER = T_TR * 2, U_ALL = NL * U_LAYER;
constexpr int U_IDLE_SHARE = 14336;
constexpr int U_IDLE_SHARE_L1 = 16384;
constexpr int U_L1_IN_S0 = 8192;
constexpr int U_EARLY = (T_IN + 4 * T_SQ) * 2;
struct TUnit { const float* src; bf16_t* dst; int N, K; };
__device__ __forceinline__ TUnit p0_unit(const Frame& F, int u) {
    const int g = u >> 3, kt = (u >> 1) & 3, hh = u & 1, l = g / (T_TR / 4); int r = g % (T_TR / 4); unsigned char* wl = F.ws + WS_W + (size_t)l * W_LAYER;
    int idx, K = D, N = D, row_off = 0; size_t wo, lsz = (size_t)D * D;
    if (r < T_IN / 4) { idx = 4; N = NIN; wo = WO_IN; lsz = (size_t)D * NIN; }
    else if ((r -= T_IN / 4) < T_SQ / 4) { idx = 5; wo = WO_OUT; }
    else if ((r -= T_SQ / 4) < T_SQ / 4) { idx = 19; wo = WO_KV; }
    else if ((r -= T_SQ / 4) < T_SQ / 4) { idx = 20; wo = WO_KV; row_off = D; }
    else if ((r -= T_SQ / 4) < T_SQ / 4) { idx = 21; wo = WO_O; }
    else if ((r -= T_SQ / 4) < T_UP / 4) { idx = 24; N = FF; wo = WO_UP; lsz = (size_t)D * FF; }
    else { r -= T_UP / 4; idx = 25; K = FF; wo = WO_DN; lsz = (size_t)D * FF; }
    const int nblk = N / 256, k0 = 64 * (r / nblk), n0 = 256 * (r % nblk) + 64 * kt + 32 * hh;
    TUnit t; t.src = inp(F, idx) + (size_t)l * lsz + (size_t)k0 * N + n0; t.dst = (bf16_t*)(wl + wo) + (size_t)(row_off + n0) * K + k0; t.N = N; t.K = K; return t;
}
__device__ __forceinline__ void p0_unit_dma(const TUnit& t, int lane, LAS unsigned char* buf) {
#pragma unroll
    for (int i = 0; i < 8; ++i)
        __builtin_amdgcn_global_load_lds((const unsigned*)(t.src + (size_t)(8 * i + (lane >> 3)) * t.N + 4 * ((lane & 7) ^ i)), (LAS unsigned*)(buf + i * 1024), 16, 0,   2);
}
__device__ __forceinline__ void p0_unit_out(const TUnit& t, int lane, const LAS float* scr) {
    const int kc = lane & 7;
#pragma unroll
    for (int j = 0; j < 4; ++j) { const int n = (lane >> 3) + 8 * j; const LAS float* s = scr + (8 * kc) * 32 + (n ^ (4 * kc));
        u32x4 o; o.x = cvt_pk_bf16(s[0 * 32], s[1 * 32]); o.y = cvt_pk_bf16(s[2 * 32], s[3 * 32]); o.z = cvt_pk_bf16(s[4 * 32], s[5 * 32]); o.w = cvt_pk_bf16(s[6 * 32], s[7 * 32]);
        *(GAS u32x4*)(t.dst + (size_t)n * t.K + 8 * kc) = o; }
}
__device__ __forceinline__ void p0_convert(Frame& F, int w0, int nw, int lo, int hi) {
    LAS unsigned char* base = F.lds + F.wave * 16384;
    int u = lo + w0; if (u >= hi) return;
    int b = 0;
    TUnit tc = p0_unit(F, u);
    p0_unit_dma(tc, F.lane, base);
    for (; u < hi; u += nw) {
        const bool more = u + nw < hi;
        TUnit tn = tc;
        if (more) { tn = p0_unit(F, u + nw); p0_unit_dma(tn, F.lane, base + (b ^ 1) * 8192); asm volatile("s_waitcnt vmcnt(8)" ::: "memory"); }
        else asm volatile("s_waitcnt vmcnt(0)" ::: "memory");
        p0_unit_out(tc, F.lane, (const LAS float*)(base + b * 8192));
        LDS_WAIT(); asm volatile("" ::: "memory");
        tc = tn; b ^= 1;
    }
}
__device__ __forceinline__ void p0_plain(Frame& F, int gw, int ngw, int l0, int l1) {
    for (int c = l0 * (D * D / 8) + gw * 64 + F.lane; c < l1 * (D * D / 8); c += ngw * 64) {
        const int l = c / (D * D / 8), r = c % (D * D / 8);
        const GAS f32x4* sp = (const GAS f32x4*)(inp(F, 18) + (size_t)l * D * D) + 2 * r; const f32x4 a = __builtin_nontemporal_load(sp), bq = __builtin_nontemporal_load(sp + 1);
        u32x4 o; o.x = cvt_pk_bf16(a.x, a.y); o.y = cvt_pk_bf16(a.z, a.w); o.z = cvt_pk_bf16(bq.x, bq.y); o.w = cvt_pk_bf16(bq.z, bq.w);
        ((GAS u32x4*)(F.ws + WS_W + (size_t)l * W_LAYER + WO_Q))[r] = o; }
}
__device__ __forceinline__ void rms_row_to_bf16(const float* xrow, const float* g, bf16_t* orow, float* cp, int lane) {
    const GAS f32x4* xr = (const GAS f32x4*)xrow + lane; f32x4 v[8]; float s = 0.f;
#pragma unroll
    for (int j = 0; j < 8; ++j) { v[j] = xr[64 * j]; s += (v[j].x * v[j].x + v[j].y * v[j].y) + (v[j].z * v[j].z + v[j].w * v[j].w); }
    const float rs = 1.f / sqrtf(wave_sum(s) * (1.f / D) + RMS_EPS);
    if (cp) { GAS f32x4* c4 = (GAS f32x4*)cp + lane;
#pragma unroll
        for (int j = 0; j < 8; ++j) c4[64 * j] = v[j]; }
    const GAS f32x4* g4 = (const GAS f32x4*)g + lane; GAS u32x2* o8 = (GAS u32x2*)orow + lane;
#pragma unroll
    for (int j = 0; j < 8; ++j) { const f32x4 gg = g4[64 * j]; u32x2 w; w.x = cvt_pk_bf16(v[j].x * rs * gg.x, v[j].y * rs * gg.y); w.y = cvt_pk_bf16(v[j].z * rs * gg.z, v[j].w * rs * gg.w); o8[64 * j] = w; }
}
__device__ __forceinline__ void p0_memnorm(Frame& F, int gw, int ngw, int l0, int l1) {
    for (int m = l0 * MM + gw; m < l1 * MM; m += ngw) { const int l = m / MM, r = m % MM;
        rms_row_to_bf16(inp(F, 1) + (size_t)r * D, inp(F, 16) + l * D, (bf16_t*)(F.ws + WS_MN) + (size_t)m * D, nullptr, F.lane); }
}
__device__ __forceinline__ void p0_prologue(Frame& F) {
    refresh(F);
    const int gw = F.vcu * NWAVES + F.wave, NGW = F.G * NWAVES;
    for (int l = 0; l < NL; ++l) p0_convert(F, gw, NGW, l * U_LAYER, (F.G == 256) ? l * U_LAYER + U_EARLY - (l == 1 ? U_L1_IN_S0 : 0) : (l + 1) * U_LAYER);
    p0_plain(F, gw, NGW, 0, (F.G == 256) ? 1 : NL);
    for (int r = gw; r < NL * PG * 128; r += NGW) {
        const float* wp = inp(F, 9) + (size_t)(r >> 7) * 128 * 128 + (r & 127);
        ((GAS unsigned*)(F.ws + WS_WPT))[(size_t)r * 64 + F.lane] = cvt_pk_bf16(wp[(2 * F.lane) * 128], wp[(2 * F.lane + 1) * 128]); }
    for (int r = gw; r < NL * GH * CH; r += NGW) {
        const int t = r & 127; const f32x2 w2 = *(const GAS f32x2*)(inp(F, 7) + (size_t)r * CH + 2 * F.lane);
        ((GAS unsigned*)(F.ws + WS_WSM))[(size_t)r * 64 + F.lane] = cvt_pk_bf16(2 * F.lane <= t ? w2.x : 0.f, 2 * F.lane + 1 <= t ? w2.y : 0.f); }
    p0_memnorm(F, gw, NGW, 0, NL);
    for (int m0 = gw; m0 < M; m0 += 4 * NGW) {
        f32x4 v[4][8];
#pragma unroll
        for (int r = 0; r < 4; ++r) { const int m = m0 + r * NGW; if (m < M) { const GAS f32x4* xr = (const GAS f32x4*)(inp(F, 0) + (size_t)m * D) + F.lane;
#pragma unroll
            for (int j = 0; j < 8; ++j) v[r][j] = xr[64 * j]; } }
#pragma unroll
        for (int r = 0; r < 4; ++r) { const int m = m0 + r * NGW; if (m < M) { float s = 0.f;
#pragma unroll
            for (int j = 0; j < 8; ++j) s += (v[r][j].x * v[r][j].x + v[r][j].y * v[r][j].y) + (v[r][j].z * v[r][j].z + v[r][j].w * v[r][j].w);
            const float rs = 1.f / sqrtf(wave_sum(s) * (1.f / D) + RMS_EPS);
            const GAS f32x4* g4 = (const GAS f32x4*)inp(F, 2) + F.lane; GAS u32x2* o8 = (GAS u32x2*)((bf16_t*)(F.ws + WS_XN) + (size_t)m * D) + F.lane;
#pragma unroll
            for (int j = 0; j < 8; ++j) { const f32x4 gg = g4[64 * j]; u32x2 w; w.x = cvt_pk_bf16(v[r][j].x * rs * gg.x, v[r][j].y * rs * gg.y); w.y = cvt_pk_bf16(v[r][j].z * rs * gg.z, v[r][j].w * rs * gg.w); o8[64 * j] = w; } } }
    }
}

template <bool IN_F32, bool OUT_F32>
__device__ __forceinline__ void norm_pass(Frame& F, const float* g_post, const float* g_pre) {
    refresh(F);
    const int gw = F.vcu * NWAVES + F.wave, NGW = F.G * NWAVES;
    const bf16_t* HB = (const bf16_t*)(F.ws + WS_HB); bf16_t* XN = (bf16_t*)(F.ws + WS_XN); unsigned short* XH = (unsigned short*)(F.ws + WS_XH);
    constexpr int NR = IN_F32 ? 2 : 4;
    const int mBeg = (F.xg >= 0) ? F.xg * 1024 + (F.vcu & 31) * NWAVES + F.wave : gw, mStep = (F.xg >= 0) ? 256 : NGW, mEnd = (F.xg >= 0) ? F.xg * 1024 + 1024 : M;
    for (int m0 = mBeg; m0 < mEnd; m0 += NR * mStep) {
        u32x2 hw[NR][8]; f32x4 xf[IN_F32 ? NR : 1][8]; u32x2 xw[IN_F32 ? 1 : NR][8];
#pragma unroll
        for (int r = 0; r < NR; ++r) { const int m = m0 + r * mStep; if (m < mEnd) {
            const GAS u32x2* hr = (const GAS u32x2*)(HB + (size_t)m * D) + F.lane;
            if constexpr (IN_F32) { const GAS f32x4* xi = (const GAS f32x4*)(inp(F, 0) + (size_t)m * D) + F.lane;
#pragma unroll
                for (int j = 0; j < 8; ++j) xf[IN_F32 ? r : 0][j] = __builtin_nontemporal_load(xi + 64 * j); }
            else { const GAS u32x2* xi = (const GAS u32x2*)(XH + (size_t)m * D) + F.lane;
#pragma unroll
                for (int j = 0; j < 8; ++j) xw[IN_F32 ? 0 : r][j] = __builtin_nontemporal_load(xi + 64 * j); }
#pragma unroll
            for (int j = 0; j < 8; ++j) hw[r][j] = __builtin_nontemporal_load(hr + 64 * j); } }
#pragma unroll
        for (int r = 0; r < NR; ++r) { const int m = m0 + r * mStep; if (m < mEnd) {
            const GAS f32x4* gp = (const GAS f32x4*)g_post + F.lane;
            f32x4 h[8], x[8]; float s = 0.f;
#pragma unroll
            for (int j = 0; j < 8; ++j) { const u32x2 w = hw[r][j]; h[j] = (f32x4){bf_lo(w.x), bf_hi(w.x), bf_lo(w.y), bf_hi(w.y)}; s += (h[j].x * h[j].x + h[j].y * h[j].y) + (h[j].z * h[j].z + h[j].w * h[j].w);
                if constexpr (IN_F32) x[j] = xf[IN_F32 ? r : 0][j]; else { const f32x2 a = unpk_f16(xw[IN_F32 ? 0 : r][j].x), b = unpk_f16(xw[IN_F32 ? 0 : r][j].y); x[j] = (f32x4){a.x, a.y, b.x, b.y}; } }
            const float rs = 1.f / sqrtf(wave_sum(s) * (1.f / D) + RMS_EPS); float s2 = 0.f;
#pragma unroll
            for (int j = 0; j < 8; ++j) { const f32x4 g = gp[64 * j]; x[j] = x[j] + h[j] * rs * g;
                if constexpr (OUT_F32) ((GAS f32x4*)(F.out + (size_t)m * D) + F.lane)[64 * j] = x[j];
                else { u32x2 w; w.x = pk_f16(x[j].x, x[j].y); w.y = pk_f16(x[j].z, x[j].w); ((GAS u32x2*)(XH + (size_t)m * D) + F.lane)[64 * j] = w; }
                s2 += (x[j].x * x[j].x + x[j].y * x[j].y) + (x[j].z * x[j].z + x[j].w * x[j].w); }
            if (g_pre) {
                const float rs2 = 1.f / sqrtf(wave_sum(s2) * (1.f / D) + RMS_EPS);
                const GAS f32x4* g4 = (const GAS f32x4*)g_pre + F.lane; GAS u32x2* o8 = (GAS u32x2*)(XN + (size_t)m * D) + F.lane;
#pragma unroll
                for (int j = 0; j < 8; ++j) { const f32x4 gg = g4[64 * j]; u32x2 w; w.x = cvt_pk_bf16(x[j].x * rs2 * gg.x, x[j].y * rs2 * gg.y); w.y = cvt_pk_bf16(x[j].z * rs2 * gg.z, x[j].w * rs2 * gg.w); o8[64 * j] = w; }
            } } }
    }
}

constexpr int LDP = 136;
__device__ __forceinline__ void small_mma(const LAS bf16_t* Tm, const LAS bf16_t* Dm, int wave, int fr, int fq, f32x4 (&acc)[8]) {
#pragma unroll
    for (int dt = 0; dt < 8; ++dt) acc[dt] = (f32x4){0.f, 0.f, 0.f, 0.f};
#pragma unroll
    for (int k = 0; k < 4; ++k) {
        const bf16x8 y = *(const LAS bf16x8*)(Tm + (16 * wave + fr) * LDP + 32 * k + 8 * fq);
#pragma unroll
        for (int dt = 0; dt < 8; ++dt) { const bf16x8 x = *(const LAS bf16x8*)(Dm + (32 * (dt >> 1) + 8 * (fr >> 2) + 4 * (dt & 1) + (fr & 3)) * LDP + 32 * k + 8 * fq);
            acc[dt] = __builtin_amdgcn_mfma_f32_16x16x32_bf16(x, y, acc[dt], 0, 0, 0); }
    }
}
__device__ __forceinline__ void gmlp_pair(Frame& F, int l, int pair) {
    refresh(F);
    const int bc = (F.xg >= 0) ? 8 * F.xg + ((pair & 31) >> 3) : pair >> 3, dbc = (F.xg >= 0) ? 4 : 32, h = pair & 7, tid = F.tid;
    LAS bf16_t* Wm = (LAS bf16_t*)F.lds; LAS bf16_t* vT0 = Wm + 128 * LDP; LAS bf16_t* vT1 = vT0 + 128 * LDP;
    const bf16_t* Z = (const bf16_t*)(F.ws + WS_BIG + BO_Z); bf16_t* Y = (bf16_t*)(F.ws + WS_BIG + BO_Y);
    const int t = tid >> 2, q4 = tid & 3;
    const int fr = F.lane & 15, fq = F.lane >> 4;
    const int tt = 16 * F.wave + fr;
    u32x4 uw[2][4];
#pragma unroll
    for (int p2 = 0; p2 < 2; ++p2) { const bf16_t* urow = Z + (size_t)((bc + dbc * p2) * CH + tt) * NIN + h * HD + 8 * fq;
#pragma unroll
        for (int j = 0; j < 4; ++j) uw[p2][j] = *(const GAS u32x4*)(urow + 32 * j); }
    {
        const GAS u32x4* wsrc = (const GAS u32x4*)((const bf16_t*)(F.ws + WS_WSM) + ((size_t)(l * GH + h) * CH + t) * CH + q4 * 32);
#pragma unroll
        for (int j = 0; j < 4; ++j) *(LAS u32x4*)(Wm + t * LDP + q4 * 32 + 8 * j) = wsrc[j];
    }
    {
        const GAS f32x4* gv4 = (const GAS f32x4*)(inp(F, 6) + (l * GH + h) * HD + q4 * 32); float gv[32];
#pragma unroll
        for (int i = 0; i < 8; ++i) { const f32x4 g = gv4[i]; gv[4 * i] = g.x; gv[4 * i + 1] = g.y; gv[4 * i + 2] = g.z; gv[4 * i + 3] = g.w; }
        u32x4 vw[2][4];
#pragma unroll
        for (int p2 = 0; p2 < 2; ++p2) { const GAS u32x4* vsrc = (const GAS u32x4*)(Z + (size_t)((bc + dbc * p2) * CH + t) * NIN + GW + h * HD + q4 * 32);
#pragma unroll
            for (int j = 0; j < 4; ++j) vw[p2][j] = vsrc[j]; }
#pragma unroll
        for (int p2 = 0; p2 < 2; ++p2) { LAS bf16_t* vT = p2 ? vT1 : vT0;
            float v[32]; float sum = 0.f;
#pragma unroll
            for (int j = 0; j < 4; ++j) { const u32x4 w = vw[p2][j];
                v[8 * j + 0] = bf_lo(w.x); v[8 * j + 1] = bf_hi(w.x); v[8 * j + 2] = bf_lo(w.y); v[8 * j + 3] = bf_hi(w.y); v[8 * j + 4] = bf_lo(w.z); v[8 * j + 5] = bf_hi(w.z); v[8 * j + 6] = bf_lo(w.w); v[8 * j + 7] = bf_hi(w.w); }
#pragma unroll
            for (int i = 0; i < 32; ++i) sum += v[i];
            sum += lx1(sum); sum += lx2(sum);
            const float mu = sum * (1.f / HD); float q = 0.f;
#pragma unroll
            for (int i = 0; i < 32; ++i) { v[i] -= mu; q += v[i] * v[i]; }
            q += lx1(q); q += lx2(q);
            const float rs = 1.f / sqrtf(q * (1.f / HD) + LN_EPS);
#pragma unroll
            for (int i = 0; i < 32; i += 2) { const unsigned w = cvt_pk_bf16(v[i] * rs * gv[i], v[i + 1] * rs * gv[i + 1]);
                vT[(q4 * 32 + i) * LDP + t] = (bf16_t)(w & 0xffffu); vT[(q4 * 32 + i + 1) * LDP + t] = (bf16_t)(w >> 16); } }
    }
    __syncthreads();
    f32x4 acc0[8], acc1[8];
#pragma unroll
    for (int dt = 0; dt < 8; ++dt) { acc0[dt] = (f32x4){0.f, 0.f, 0.f, 0.f}; acc1[dt] = (f32x4){0.f, 0.f, 0.f, 0.f}; }
#pragma unroll
    for (int k = 0; k < 4; ++k) {
        const bf16x8 y = *(const LAS bf16x8*)(Wm + (16 * F.wave + fr) * LDP + 32 * k + 8 * fq);
#pragma unroll
        for (int dt = 0; dt < 8; ++dt) { const int drow = (32 * (dt >> 1) + 8 * (fr >> 2) + 4 * (dt & 1) + (fr & 3)) * LDP + 32 * k + 8 * fq;
            acc0[dt] = __builtin_amdgcn_mfma_f32_16x16x32_bf16(*(const LAS bf16x8*)(vT0 + drow), y, acc0[dt], 0, 0, 0);
            acc1[dt] = __builtin_amdgcn_mfma_f32_16x16x32_bf16(*(const LAS bf16x8*)(vT1 + drow), y, acc1[dt], 0, 0, 0); }
    }
    {
        const float bsv = inp(F, 8)[(l * GH + h) * CH + tt];
#pragma unroll
        for (int p2 = 0; p2 < 2; ++p2) { bf16_t* yrow = Y + (size_t)((bc + dbc * p2) * CH + tt) * D + h * HD + 8 * fq;
#pragma unroll
            for (int j = 0; j < 4; ++j) { const f32x4 a = p2 ? acc1[2 * j] : acc0[2 * j], b = p2 ? acc1[2 * j + 1] : acc0[2 * j + 1]; const u32x4 uu = uw[p2][j];
                u32x4 o; o.x = cvt_pk_bf16(bf_lo(uu.x) * (a[0] + bsv), bf_hi(uu.x) * (a[1] + bsv)); o.y = cvt_pk_bf16(bf_lo(uu.y) * (a[2] + bsv), bf_hi(uu.y) * (a[3] + bsv));
                o.z = cvt_pk_bf16(bf_lo(uu.z) * (b[0] + bsv), bf_hi(uu.z) * (b[1] + bsv)); o.w = cvt_pk_bf16(bf_lo(uu.w) * (b[2] + bsv), bf_hi(uu.w) * (b[3] + bsv));
                *(GAS u32x4*)(yrow + 32 * j) = o; } }
    }
    __syncthreads();
}
struct PoolRegs { u32x4 z[5]; u32x4 w[4]; };
__device__ __forceinline__ void pool_load(Frame& F, int l, int unit, PoolRegs& R) {
    refresh(F);
    const int bc = unit >> 2, g = unit & 3, row0 = bc * CH, cseq = bc & 15, tid = F.tid;
    const bf16_t* Z = (const bf16_t*)(F.ws + WS_BIG + BO_Z);
#pragma unroll
    for (int k = 0; k < 5; ++k) { const int ch = tid + 512 * k, i = ch >> 4, c16 = ch & 15; R.z[k] = (u32x4){0u, 0u, 0u, 0u};
        if (ch < 144 * 16 && (cseq > 0 || i >= 16)) R.z[k] = *(const GAS u32x4*)(Z + (size_t)(row0 - 16 + i) * NIN + 2 * GW + g * 128 + c16 * 8); }
    const int d = tid >> 2, q4 = tid & 3; const GAS u32x4* wsrc = (const GAS u32x4*)((const bf16_t*)(F.ws + WS_WPT) + ((size_t)(l * PG + g) * 128 + d) * 128 + q4 * 32);
#pragma unroll
    for (int j = 0; j < 4; ++j) R.w[j] = wsrc[j];
}
__device__ __forceinline__ void pool_unit(Frame& F, int l, int unit, const PoolRegs& R) {
    refresh(F);
    const int bc = unit >> 2, g = unit & 3, row0 = bc * CH, cseq = bc & 15, w = 2 << g, tid = F.tid;
    LAS unsigned* Pt = (LAS unsigned*)F.lds;
    LAS bf16_t* Pl = (LAS bf16_t*)(F.lds + 36864); LAS bf16_t* WpT = Pl + 128 * LDP;
    bf16_t* Y = (bf16_t*)(F.ws + WS_BIG + BO_Y);
#pragma unroll
    for (int k = 0; k < 5; ++k) { const int ch = tid + 512 * k, i = ch >> 4, c16 = ch & 15; if (ch < 144 * 16) *(LAS u32x4*)(Pt + i * 64 + c16 * 4) = R.z[k]; }
    {
        const int d = tid >> 2, q4 = tid & 3;
#pragma unroll
        for (int j = 0; j < 4; ++j) *(LAS u32x4*)(WpT + d * LDP + q4 * 32 + 8 * j) = R.w[j];
    }
    __syncthreads();
    {
        const int cp = tid & 63, tg = tid >> 6, i0 = tg * 16 + 16;
        float s0 = 0.f, s1 = 0.f;
        for (int j = 1; j < w; ++j) { const unsigned d = Pt[(i0 - j) * 64 + cp]; s0 += bf_lo(d); s1 += bf_hi(d); }
#pragma unroll
        for (int tt = 0; tt < 16; ++tt) { const int t = tg * 16 + tt, i = t + 16, pos = cseq * CH + t;
            const unsigned self = Pt[i * 64 + cp]; s0 += bf_lo(self); s1 += bf_hi(self);
            const float inv = 1.f / (float)((pos + 1) < w ? (pos + 1) : w);
            ((LAS unsigned*)Pl)[t * (LDP / 2) + cp] = cvt_pk_bf16(s0 * inv - bf_lo(self), s1 * inv - bf_hi(self));
            const unsigned old = Pt[(i - w + 1) * 64 + cp]; s0 -= bf_lo(old); s1 -= bf_hi(old); }
    }
    __syncthreads();
    const int fr = F.lane & 15, fq = F.lane >> 4;
    f32x4 acc[8];
    small_mma(Pl, WpT, F.wave, fr, fq, acc);
    {
        const int tt = 16 * F.wave + fr; const float* sp = inp(F, 10) + l * PW + g * 128 + 8 * fq; bf16_t* yrow = Y + (size_t)(row0 + tt) * D + GW + g * 128 + 8 * fq;
#pragma unroll
        for (int j = 0; j < 4; ++j) { const f32x4 s0 = *(const GAS f32x4*)(sp + 32 * j), s1 = *(const GAS f32x4*)(sp + 32 * j + 4); const f32x4 a = acc[2 * j], b = acc[2 * j + 1];
            u32x4 o; o.x = cvt_pk_bf16(a[0] * s0.x, a[1] * s0.y); o.y = cvt_pk_bf16(a[2] * s0.z, a[3] * s0.w); o.z = cvt_pk_bf16(b[0] * s1.x, b[1] * s1.y); o.w = cvt_pk_bf16(b[2] * s1.z, b[3] * s1.w);
            *(GAS u32x4*)(yrow + 32 * j) = o; }
    }
    __syncthreads();
}
constexpr int CT = 32, CR = CT + CK - 1;
template <int I> __device__ __forceinline__ void conv_taps(float (&acc)[CT], const float (&wj)[CK], const LAS bf16_t* Hc) {
    if constexpr (I < CR) {
        const float hv = __builtin_bit_cast(float, (unsigned)Hc[I * 512] << 16);
        constexpr int T0 = (I - (CK - 1) > 0) ? I - (CK - 1) : 0, T1 = (I < CT - 1) ? I : CT - 1;
#pragma unroll
        for (int t = T0; t <= T1; ++t) acc[t] += wj[I - t] * hv;
        conv_taps<I + 1>(acc, wj, Hc);
    }
}
constexpr int CONV_NP = CR * 64, CONV_NK = (CONV_NP + 511) / 512;
struct ConvRegs { u32x4 cv[CONV_NK], cg[CONV_NK]; };
__device__ __forceinline__ void conv_load(Frame& F, int unit, ConvRegs& R) {
    refresh(F);
    const int row0 = unit * CT, pos0 = row0 & (SEQ - 1), c = F.tid;
    const bf16_t* Z = (const bf16_t*)(F.ws + WS_BIG + BO_Z);
#pragma unroll
    for (int k = 0; k < CONV_NK; ++k) { const int p = (c + 512 * k < CONV_NP) ? c + 512 * k : c; const int i = p >> 6, grp = p & 63; const bool ok = (pos0 - (CK - 1) + i) >= 0;
        const bf16_t* zr = Z + (size_t)(ok ? row0 - (CK - 1) + i : row0) * NIN + 2 * GW + PW + 8 * grp;
        R.cv[k] = *(const GAS u32x4*)zr; R.cg[k] = *(const GAS u32x4*)(zr + CW); }
}
__device__ __forceinline__ void conv_unit(Frame& F, int l, int unit, const float (&wj)[CK], const ConvRegs& R) {
    refresh(F);
    const int row0 = unit * CT, pos0 = row0 & (SEQ - 1), c = F.tid;
    bf16_t* Y = (bf16_t*)(F.ws + WS_BIG + BO_Y);
    LAS bf16_t* H = (LAS bf16_t*)F.lds;
    LAS float* CV = (LAS float*)(F.lds + CR * 512 * 2);
    {
        constexpr int NP = CONV_NP, NK = CONV_NK;
        const u32x4 (&cv)[NK] = R.cv; const u32x4 (&cg)[NK] = R.cg;
#pragma unroll
        for (int k = 0; k < NK; ++k) { const int p = c + 512 * k; if (p < NP) { const int i = p >> 6, grp = p & 63; const float ok = (pos0 - (CK - 1) + i) >= 0 ? 1.f : 0.f;
            u32x4 o;
            o.x = cvt_pk_bf16(ok * bf_lo(cv[k].x) * fast_sigmoid(bf_lo(cg[k].x)), ok * bf_hi(cv[k].x) * fast_sigmoid(bf_hi(cg[k].x)));
            o.y = cvt_pk_bf16(ok * bf_lo(cv[k].y) * fast_sigmoid(bf_lo(cg[k].y)), ok * bf_hi(cv[k].y) * fast_sigmoid(bf_hi(cg[k].y)));
            o.z = cvt_pk_bf16(ok * bf_lo(cv[k].z) * fast_sigmoid(bf_lo(cg[k].z)), ok * bf_hi(cv[k].z) * fast_sigmoid(bf_hi(cg[k].z)));
            o.w = cvt_pk_bf16(ok * bf_lo(cv[k].w) * fast_sigmoid(bf_lo(cg[k].w)), ok * bf_hi(cv[k].w) * fast_sigmoid(bf_hi(cg[k].w)));
            *(LAS u32x4*)(H + i * 512 + 8 * grp) = o; } }
    }
    __syncthreads();
    float acc[CT];
#pragma unroll
    for (int t = 0; t < CT; ++t) acc[t] = 0.f;
    conv_taps<0>(acc, wj, H + c);
    const float bd = inp(F, 12)[l * CW + c];
#pragma unroll
    for (int t = 0; t < CT; ++t) CV[t * 512 + c] = acc[t] + bd;
    __syncthreads();
    const GAS f32x4* lg = (const GAS f32x4*)(inp(F, 13) + l * CW) + 2 * F.lane; const GAS f32x4* lb = (const GAS f32x4*)(inp(F, 14) + l * CW) + 2 * F.lane;
    const f32x4 g0 = lg[0], g1 = lg[1], b0 = lb[0], b1 = lb[1];
#pragma unroll
    for (int k = 0; k < CT / 8; ++k) { const int t = (CT / 8) * F.wave + k;
        f32x4 a = *(const LAS f32x4*)(CV + t * 512 + 8 * F.lane), b = *(const LAS f32x4*)(CV + t * 512 + 8 * F.lane + 4);
        const float mu = wave_sum((a.x + a.y) + (a.z + a.w) + (b.x + b.y) + (b.z + b.w)) * (1.f / CW);
        a = a - mu; b = b - mu;
        const float var = wave_sum((a.x * a.x + a.y * a.y) + (a.z * a.z + a.w * a.w) + (b.x * b.x + b.y * b.y) + (b.z * b.z + b.w * b.w)) * (1.f / CW);
        const float rs = 1.f / sqrtf(var + LN_EPS);
        a = a * rs * g0 + b0; b = b * rs * g1 + b1;
        u32x4 o; o.x = cvt_pk_bf16(a.x * fast_sigmoid(a.x), a.y * fast_sigmoid(a.y)); o.y = cvt_pk_bf16(a.z * fast_sigmoid(a.z), a.w * fast_sigmoid(a.w));
        o.z = cvt_pk_bf16(b.x * fast_sigmoid(b.x), b.y * fast_sigmoid(b.y)); o.w = cvt_pk_bf16(b.z * fast_sigmoid(b.z), b.w * fast_sigmoid(b.w));
        *(GAS u32x4*)(Y + (size_t)(row0 + t) * D + GW + PW + 8 * F.lane) = o; }
    __syncthreads();
}
static_assert((M / CH) * GH / 2 == 256 && (M / CH) * PG == 256 && M / CT == 256, "the three mixers have 256 units each");
__device__ __forceinline__ void mixer_phase(Frame& F, int l) {
    float wj[CK]; { const float* wdw = inp(F, 11) + (size_t)l * CK * CW + fresh_tid();
#pragma unroll
        for (int j = 0; j < CK; ++j) wj[j] = wdw[j * CW]; }
    for (int u = F.vcu; u < 256; u += F.G) {
        PoolRegs PR; pool_load(F, l, u, PR);
        gmlp_pair(F, l, u);
        ConvRegs CRg; conv_load(F, u, CRg);
        pool_unit(F, l, u, PR);
        conv_unit(F, l, u, wj, CRg);
    }
}

struct Args { const float* in[26]; float* out; unsigned char* ws; int stop, rep; };
__global__ void __launch_bounds__(NWAVES * 64, 2) mega_fwd(Args args) {
    extern __shared__ __attribute__((aligned(16))) unsigned char lds[];
    Frame F;
    F.lds = (LAS unsigned char*)lds;
    F.tid = threadIdx.x; F.lane = F.tid & 63; F.wave = __builtin_amdgcn_readfirstlane(F.tid >> 6);
    F.G = gridDim.x; { const int bx = blockIdx.x; F.vcu = (F.G % 8 == 0) ? (bx % 8) * (F.G / 8) + bx / 8 : bx; }
    F.kp = __builtin_amdgcn_kernarg_segment_ptr();
    F.xg = (F.G == 256) ? (F.vcu >> 5) : -1; F.local = false;
    F.out = args.out; F.ws = args.ws;
    for (int u = F.tid; u < (LDS_BYTES - LDSCTL_OFF) / 4; u += NWAVES * 64) ((LAS unsigned*)(F.lds + LDSCTL_OFF))[u] = 0u;
    __syncthreads();
    const XcdBarrier bar = xcd_barrier_post((unsigned*)(F.ws + WS_CTL) + CW_BAR, (volatile LAS unsigned*)(F.lds + MISC_OFF) + 8);
#define GRID_BAR() do { xcd_barrier(bar); if (++ph >= args.stop) return; } while (0)
#define GRID_BAR_LOCAL() do { xcd_barrier(bar, F.local); if (++ph >= args.stop) return; } while (0)
    int ph = 0;
    const int cid0 = (int)blockIdx.x;
#define cid opaque_s(cid0)
#define sc opaque_s((F.xg >= 0) ? (F.vcu & 31) : cid0)
    const char* XN = (const char*)(F.ws + WS_XN); float* HB = (float*)(F.ws + WS_HB);
    unsigned char* BIG = F.ws + WS_BIG;

    if (F.xg >= 0 && F.tid == 0) __hip_atomic_store((unsigned*)(F.ws + WS_CTL) + CW_XCC + cid0, xb_xcc_id() + 1u, __ATOMIC_RELAXED, __HIP_MEMORY_SCOPE_AGENT);
    for (int r_ = 0; r_ < (args.rep == 0 ? 2 : 1); ++r_) p0_prologue(F);
    if (args.rep == 100) for (int r_ = 0; r_ < 50; ++r_) xcd_barrier(bar);
    GRID_BAR();
    if (F.xg >= 0) {
        refresh(F); LAS unsigned* okw = (LAS unsigned*)(F.lds + MISC_OFF) + 16;
        if (F.tid < 256) { const unsigned mine = __hip_atomic_load((unsigned*)(F.ws + WS_CTL) + CW_XCC + F.tid, __ATOMIC_RELAXED, __HIP_MEMORY_SCOPE_AGENT), lead = __hip_atomic_load((unsigned*)(F.ws + WS_CTL) + CW_XCC + (F.tid & 7), __ATOMIC_RELAXED, __HIP_MEMORY_SCOPE_AGENT);
            const bool ok = __all(mine != 0u && mine == lead); if (F.lane == 0) okw[F.wave] = ok ? 1u : 0u; }
        LDS_WAIT(); __syncthreads();
        F.local = (okw[0] & okw[1] & okw[2] & okw[3]) != 0u;
        __syncthreads();
    }
    for (int l = 0; l < NL; ++l) {
        const unsigned char* wl = F.ws + WS_W + (size_t)l * W_LAYER;
        const char* MN = (const char*)(F.ws + WS_MN) + (size_t)l * MM * D * 2;
        for (int r_ = 0; r_ < (args.rep == 1 ? 2 : 1); ++r_)
        { SchedIn S{(const char*)F.ws, (const char*)wl, MN, F.G, sc, F.xg};
          pg8::gemm_phase<pg8::EpiBf16<1>, SchedIn>(F.lds, D, D, S, pg8::EpiBf16<1>{}); }
        GRID_BAR();
        for (int r_ = 0; r_ < (args.rep == 2 ? 2 : 1); ++r_) mixer_phase(F, l);
        GRID_BAR_LOCAL();
        for (int r_ = 0; r_ < (args.rep == 3 ? 2 : 1); ++r_)
        { SchedGU S{(const char*)F.ws, (const char*)wl, F.G, sc, F.xg}; pg8::gemm_phase<pg8::EpiBf16<0>, SchedGU>(F.lds, D, D, S, pg8::EpiBf16<0>{}); }
        GRID_BAR();
        if (l == 0) norm_pass<true, false>(F, inp(F, 3) + l * D, inp(F, 15) + l * D); else norm_pass<false, false>(F, inp(F, 3) + l * D, inp(F, 15) + l * D);
        GRID_BAR_LOCAL();
        for (int r_ = 0; r_ < (args.rep == 6 ? 2 : 1); ++r_) {
        { SchedS S{XN, (const char*)(BIG + BO_GT), BIG + BO_P, F.G, sc, F.xg};
          pg8::gemm_phase<pg8::EpiSoftmax, SchedS>(F.lds, D, D, S, pg8::EpiSoftmax{0.044194173824159216f * 1.44269504089f}); }
        if (F.G == 256) {
            refresh(F); const int lo = l * U_LAYER + U_EARLY, mid = lo + (l == 0 ? U_IDLE_SHARE : U_IDLE_SHARE_L1), hi = (l + 1) * U_LAYER;
            if (cid0 >= 128) { p0_convert(F, (cid0 - 128) * NWAVES + F.wave, 128 * NWAVES, lo, mid); if (l == 0) { p0_convert(F, (cid0 - 128) * NWAVES + F.wave, 128 * NWAVES, U_LAYER + U_EARLY - U_L1_IN_S0, U_LAYER + U_EARLY); p0_plain(F, (cid0 - 128) * NWAVES + F.wave, 128 * NWAVES, 1, NL); } }
            else { __syncthreads();   p0_convert(F, cid0 * NWAVES + F.wave, 128 * NWAVES, mid, hi); } }
        }
        GRID_BAR();
        for (int r_ = 0; r_ < (args.rep == 8 ? 2 : 1); ++r_)
        { SchedO S{(const char*)(BIG + BO_P), (const char*)(BIG + BO_UT), HB, F.G, sc, F.xg};
          pg8::gemm_phase<pg8::EpiBf16<0>, SchedO>(F.lds, XH * MEM, XH * MEM, S, pg8::EpiBf16<0>{}); }
        GRID_BAR_LOCAL();
        norm_pass<false, false>(F, inp(F, 17) + l * D, inp(F, 22) + l * D);
        GRID_BAR_LOCAL();
        for (int r_ = 0; r_ < (args.rep == 10 ? 2 : 1); ++r_)
        { typedef SchedPlain<D, D, FF, M / 256, FF / 256, D> SP; SP S{XN, (const char*)(wl + WO_UP), BIG + BO_UP, F.G, sc, F.xg};
          pg8::gemm_phase<pg8::EpiBf16<2>, SP>(F.lds, D, D, S, pg8::EpiBf16<2>{}); }
        GRID_BAR_LOCAL();
        for (int r_ = 0; r_ < (args.rep == 11 ? 2 : 1); ++r_)
        { typedef SchedPlain<FF, FF, D, M / 256, D / 256, FF> SP; SP S{(const char*)(BIG + BO_UP), (const char*)(wl + WO_DN), HB, F.G, sc, F.xg};
          pg8::gemm_phase<pg8::EpiBf16<0>, SP>(F.lds, FF, FF, S, pg8::EpiBf16<0>{}); }
        GRID_BAR_LOCAL();
        if (l + 1 < NL) norm_pass<false, false>(F, inp(F, 23) + l * D, inp(F, 2) + (l + 1) * D); else norm_pass<false, true>(F, inp(F, 23) + l * D, nullptr);
        if (l + 1 < NL) GRID_BAR();
    }
}


#ifndef DBG_CUT
#define DBG_CUT 6
#endif
#ifndef PROBE_REP
#define PROBE_REP -1
#endif
#if DBG_CUT < 6
namespace nv {
constexpr int D = 2048, B = 4, S = 2048, L = 2, MEM = 256, HD = 128, CH = 128;
constexpr int GW = 1024, PW = 512, CW = 512, NIN = 3584, GH = 8, PG = 4, CK = 31, XH = 4, XD = 512, FF = 8192;
constexpr int M = B * S, MM = B * MEM;
constexpr float RMS_EPS = 1e-6f, LN_EPS = 1e-5f;

__device__ __forceinline__ float gelu_tanh(float x) { const float u = 0.7978845608028654f * (x + 0.044715f * x * x * x); return 0.5f * x * (1.f + tanhf(u)); }
__device__ __forceinline__ float sigmoidf(float x) { return 1.f / (1.f + expf(-x)); }

__device__ __forceinline__ float block_sum(float v, float* red) {
    for (int o = 32; o > 0; o >>= 1) v += __shfl_xor(v, o);
    __syncthreads();
    if ((threadIdx.x & 63) == 0) red[threadIdx.x >> 6] = v;
    __syncthreads();
    float s = 0.f; for (int i = 0; i < (int)(blockDim.x >> 6); ++i) s += red[i];
    return s;
}

template <int ACC> __global__ void __launch_bounds__(256) k_rmsnorm(const float* in, const float* g, float* out, int ncols) {
    __shared__ float red[8];
    const float* r = in + (size_t)blockIdx.x * ncols; float* o = out + (size_t)blockIdx.x * ncols;
    float s = 0.f; for (int c = threadIdx.x; c < ncols; c += 256) { const float v = r[c]; s += v * v; }
    s = block_sum(s, red);
    const float rs = rsqrtf(s / ncols + RMS_EPS);
    for (int c = threadIdx.x; c < ncols; c += 256) { const float v = r[c] * rs * g[c]; if (ACC) o[c] += v; else o[c] = v; }
}

template <int EPI> __global__ void __launch_bounds__(256) k_gemm(const float* A, const float* Bm, float* C, int Mr, int N, int K, int ngelu) {
    __shared__ float As[16][65], Bs[16][65];
    const int tx = threadIdx.x & 15, ty = threadIdx.x >> 4, m0 = blockIdx.y * 64, n0 = blockIdx.x * 64;
    float acc[4][4] = {};
    for (int k0 = 0; k0 < K; k0 += 16) {
        for (int i = threadIdx.x; i < 1024; i += 256) { const int r = i >> 4, c = i & 15; As[c][r] = A[(size_t)(m0 + r) * K + k0 + c]; }
        for (int i = threadIdx.x; i < 1024; i += 256) { const int r = i >> 6, c = i & 63; Bs[r][c] = Bm[(size_t)(k0 + r) * N + n0 + c]; }
        __syncthreads();
#pragma unroll
        for (int kk = 0; kk < 16; ++kk) {
            float a[4], b[4];
#pragma unroll
            for (int i = 0; i < 4; ++i) { a[i] = As[kk][ty * 4 + i]; b[i] = Bs[kk][tx * 4 + i]; }
#pragma unroll
            for (int i = 0; i < 4; ++i)
#pragma unroll
                for (int j = 0; j < 4; ++j) acc[i][j] += a[i] * b[j];
        }
        __syncthreads();
    }
#pragma unroll
    for (int i = 0; i < 4; ++i)
#pragma unroll
        for (int j = 0; j < 4; ++j) {
            const int r = m0 + ty * 4 + i, c = n0 + tx * 4 + j; float v = acc[i][j];
            if (EPI == 1) { if (c < ngelu) v = gelu_tanh(v); }
            if (EPI == 2) { v = v > 0.f ? v * v : 0.f; }
            C[(size_t)r * N + c] = v;
        }
}

__global__ void __launch_bounds__(256) k_gmlp(const float* z, const float* gv, const float* ws, const float* bs, float* y) {
    __shared__ float v[128][129];
    const int cb = blockIdx.x, h = blockIdx.y, row0 = cb * CH, tid = threadIdx.x;
    for (int i = tid; i < 128 * 128; i += 256) { const int s = i >> 7, d = i & 127; v[s][d] = z[(size_t)(row0 + s) * NIN + GW + h * HD + d]; }
    __syncthreads();
    if (tid < 128) {
        float mu = 0.f; for (int d = 0; d < 128; ++d) mu += v[tid][d]; mu *= (1.f / 128.f);
        float var = 0.f; for (int d = 0; d < 128; ++d) { const float e = v[tid][d] - mu; var += e * e; } var *= (1.f / 128.f);
        const float rs = rsqrtf(var + LN_EPS);
        for (int d = 0; d < 128; ++d) v[tid][d] = (v[tid][d] - mu) * rs * gv[h * HD + d];
    }
    __syncthreads();
    const int d = tid & 127, th = tid >> 7;
    for (int t = th * 64; t < th * 64 + 64; ++t) {
        const float* w = ws + ((size_t)h * CH + t) * CH; float acc = 0.f;
        for (int s = 0; s <= t; ++s) acc += w[s] * v[s][d];
        acc += bs[h * CH + t];
        const size_t r = (size_t)(row0 + t);
        y[r * D + h * HD + d] = z[r * NIN + h * HD + d] * acc;
    }
}

__global__ void __launch_bounds__(256) k_pool(const float* z, const float* wp, const float* sp, float* y) {
    __shared__ float pl[64][129];
    const int tb = blockIdx.x, g = blockIdx.y, row0 = tb * 64, tid = threadIdx.x;
    const int wins[4] = {2, 4, 8, 16}; const int w = wins[g];
    for (int i = tid; i < 64 * 128; i += 256) {
        const int tt = i >> 7, c = i & 127, row = row0 + tt, t = row % S;
        float sum = 0.f; const int lo = (t - w + 1) < 0 ? 0 : (t - w + 1);
        for (int s = lo; s <= t; ++s) sum += z[(size_t)(row - t + s) * NIN + 2 * GW + g * 128 + c];
        const float cnt = (float)((t + 1) < w ? (t + 1) : w);
        pl[tt][c] = sum / cnt - z[(size_t)row * NIN + 2 * GW + g * 128 + c];
    }
    __syncthreads();
    const int d = tid & 127, th = tid >> 7;
    for (int tt = th * 32; tt < th * 32 + 32; ++tt) {
        float acc = 0.f; for (int c = 0; c < 128; ++c) acc += pl[tt][c] * wp[((size_t)g * 128 + c) * 128 + d];
        y[(size_t)(row0 + tt) * D + GW + g * 128 + d] = acc * sp[g * 128 + d];
    }
}

__global__ void __launch_bounds__(512) k_conv(const float* z, const float* wdw, const float* bdw, const float* lg, const float* lb, float* y) {
    __shared__ float red[8];
    const int row = blockIdx.x, t = row % S, c = threadIdx.x;
    float acc = 0.f;
    for (int j = 0; j < CK; ++j) { const int ts = t + j - (CK - 1); if (ts < 0) continue; const size_t r = (size_t)(row - t + ts);
        const float cv = z[r * NIN + 2 * GW + PW + c], cg = z[r * NIN + 2 * GW + PW + CW + c]; acc += wdw[j * CW + c] * (cv * sigmoidf(cg)); }
    acc += bdw[c];
    float s = acc; for (int o = 32; o > 0; o >>= 1) s += __shfl_xor(s, o);
    if ((c & 63) == 0) red[c >> 6] = s; __syncthreads();
    float mu = 0.f; for (int i = 0; i < 8; ++i) mu += red[i]; mu *= (1.f / 512.f);
    __syncthreads();
    const float e = acc - mu; float q = e * e; for (int o = 32; o > 0; o >>= 1) q += __shfl_xor(q, o);
    if ((c & 63) == 0) red[c >> 6] = q; __syncthreads();
    float var = 0.f; for (int i = 0; i < 8; ++i) var += red[i]; var *= (1.f / 512.f);
    const float ln = e * rsqrtf(var + LN_EPS) * lg[c] + lb[c];
    y[(size_t)row * D + GW + PW + c] = ln * sigmoidf(ln);
}

__global__ void __launch_bounds__(256) k_attn(const float* q, const float* kk, const float* vv, float* o) {
    __shared__ float qs[512], p[256], red[8];
    const int row = blockIdx.x, h = blockIdx.y, b = row / S, j = threadIdx.x;
    qs[j] = q[(size_t)row * D + h * XD + j]; qs[j + 256] = q[(size_t)row * D + h * XD + 256 + j];
    __syncthreads();
    const float* kr = kk + (size_t)(b * MEM + j) * D + h * XD; float sc = 0.f;
    for (int d = 0; d < XD; ++d) sc += qs[d] * kr[d];
    sc *= 0.044194173824159216f;
    float mx = sc; for (int o2 = 32; o2 > 0; o2 >>= 1) mx = fmaxf(mx, __shfl_xor(mx, o2));
    if ((j & 63) == 0) red[j >> 6] = mx; __syncthreads();
    mx = fmaxf(fmaxf(red[0], red[1]), fmaxf(red[2], red[3])); __syncthreads();
    const float e = expf(sc - mx); float sm = e; for (int o2 = 32; o2 > 0; o2 >>= 1) sm += __shfl_xor(sm, o2);
    if ((j & 63) == 0) red[j >> 6] = sm; __syncthreads();
    sm = red[0] + red[1] + red[2] + red[3];
    p[j] = e / sm; __syncthreads();
    for (int d = j; d < XD; d += 256) { float acc = 0.f; for (int m = 0; m < MEM; ++m) acc += p[m] * vv[(size_t)(b * MEM + m) * D + h * XD + d]; o[(size_t)row * D + h * XD + d] = acc; }
}
}
__global__ void k_bf2f(const unsigned short* in, float* out, size_t n) { size_t i = (size_t)blockIdx.x * 256 + threadIdx.x; if (i < n) out[i] = __builtin_bit_cast(float, (unsigned)in[i] << 16); }
__global__ void k_bf2f_t(const unsigned short* in, float* out, int R, int C) {
    size_t i = (size_t)blockIdx.x * 256 + threadIdx.x; if (i < (size_t)R * C) { const int r = i / C, c = i % C; out[(size_t)c * R + r] = __builtin_bit_cast(float, (unsigned)in[i] << 16); } }
__global__ void k_bf2f_cols(const unsigned short* in, float* out, int R, int C, int c0, int c1) {
    size_t i = (size_t)blockIdx.x * 256 + threadIdx.x; const int w = c1 - c0; if (i < (size_t)R * w) { const int r = i / w, c = c0 + i % w; out[(size_t)r * C + c] = __builtin_bit_cast(float, (unsigned)in[(size_t)r * C + c] << 16); } }
#ifndef DBG_MODE
#define DBG_MODE 7
#endif
static void naive_from(void* const* d_in, void* d_out, void* d_ws, hipStream_t stream, int from) {
    using nv::k_rmsnorm; using nv::k_gemm; using nv::k_gmlp; using nv::k_pool; using nv::k_conv; using nv::k_attn;
    const float* mem = (const float*)d_in[1];
    const float *n_mix_pre = (const float*)d_in[2], *n_mix_post = (const float*)d_in[3], *w_in = (const float*)d_in[4], *w_out = (const float*)d_in[5], *g_v = (const float*)d_in[6],
                *w_sp = (const float*)d_in[7], *b_sp = (const float*)d_in[8], *w_pool = (const float*)d_in[9], *s_pool = (const float*)d_in[10], *w_dw = (const float*)d_in[11], *b_dw = (const float*)d_in[12],
                *cln_g = (const float*)d_in[13], *cln_b = (const float*)d_in[14], *n_xa_pre = (const float*)d_in[15], *n_mem = (const float*)d_in[16], *n_xa_post = (const float*)d_in[17],
                *w_q = (const float*)d_in[18], *w_k = (const float*)d_in[19], *w_v = (const float*)d_in[20], *w_o = (const float*)d_in[21], *n_ffn_pre = (const float*)d_in[22], *n_ffn_post = (const float*)d_in[23],
                *w_up = (const float*)d_in[24], *w_down = (const float*)d_in[25];
    float* xr = (float*)d_out;
    const size_t MD = (size_t)nv::M * nv::D;
    float* ws = (float*)d_ws;
    float* hn = ws; float* hb = hn + MD; float* mn = hb + MD; float* kk = mn + (size_t)nv::MM * nv::D; float* vv = kk + (size_t)nv::MM * nv::D; float* big = vv + (size_t)nv::MM * nv::D;
    float* z = big; float* y = big + (size_t)nv::M * nv::NIN; float* q = big; float* o = big + MD; float* up = big;
    const unsigned char* mws = (const unsigned char*)d_ws;
    if (DBG_MODE == 1 || DBG_MODE == 2 || (DBG_MODE >= 5 && DBG_MODE <= 7)) {
        const int l = 0;
        if (DBG_MODE != 2) {
            k_bf2f<<<(unsigned)(((size_t)nv::M * nv::NIN + 255) / 256), 256, 0, stream>>>((const unsigned short*)(mws + WS_BIG + BO_Z), z, (size_t)nv::M * nv::NIN);
            k_gmlp<<<dim3(nv::M / nv::CH, nv::GH), 256, 0, stream>>>(z, g_v + l * nv::GH * nv::HD, w_sp + (size_t)l * nv::GH * nv::CH * nv::CH, b_sp + l * nv::GH * nv::CH, y);
            k_pool<<<dim3(nv::M / 64, nv::PG), 256, 0, stream>>>(z, w_pool + (size_t)l * nv::PG * 128 * 128, s_pool + l * nv::PW, y);
            k_conv<<<nv::M, 512, 0, stream>>>(z, w_dw + (size_t)l * nv::CK * nv::CW, b_dw + l * nv::CW, cln_g + l * nv::CW, cln_b + l * nv::CW, y);
            if (DBG_MODE >= 5) { const int c0 = DBG_MODE == 5 ? 0 : (DBG_MODE == 6 ? 1024 : 1536), c1 = DBG_MODE == 5 ? 1024 : (DBG_MODE == 6 ? 1536 : 2048);
                k_bf2f_cols<<<(unsigned)(((size_t)nv::M * (c1 - c0) + 255) / 256), 256, 0, stream>>>((const unsigned short*)(mws + WS_BIG + BO_Y), y, nv::M, nv::D, c0, c1); }
        } else {
            k_bf2f<<<(unsigned)((MD + 255) / 256), 256, 0, stream>>>((const unsigned short*)(mws + WS_BIG + BO_Y), y, MD);
        }
        k_gemm<0><<<dim3(nv::D / 64, nv::M / 64), 256, 0, stream>>>(y, w_out + (size_t)l * nv::D * nv::D, hb, nv::M, nv::D, nv::D, 0);
        k_rmsnorm<1><<<nv::M, 256, 0, stream>>>(hb, n_mix_post + l * nv::D, xr, nv::D);
    }
    if (DBG_MODE == 3 || DBG_MODE == 4) {
        const int l = 0;
        if (DBG_MODE == 3) {
            k_bf2f<<<(unsigned)((MD + 255) / 256), 256, 0, stream>>>((const unsigned short*)(mws + WS_BIG + BO_Q), q, MD);
            k_bf2f<<<(unsigned)(((size_t)nv::MM * nv::D + 255) / 256), 256, 0, stream>>>((const unsigned short*)(mws + WS_KB), kk, (size_t)nv::MM * nv::D);
            k_bf2f_t<<<(unsigned)(((size_t)nv::MM * nv::D + 255) / 256), 256, 0, stream>>>((const unsigned short*)(mws + WS_VT), vv, nv::D, nv::MM);
            k_attn<<<dim3(nv::M, nv::XH), 256, 0, stream>>>(q, kk, vv, o);
        } else {
            k_bf2f<<<(unsigned)((MD + 255) / 256), 256, 0, stream>>>((const unsigned short*)(mws + WS_BIG + BO_O), o, MD);
        }
        k_gemm<0><<<dim3(nv::D / 64, nv::M / 64), 256, 0, stream>>>(o, w_o + (size_t)l * nv::D * nv::D, hb, nv::M, nv::D, nv::D, 0);
        k_rmsnorm<1><<<nv::M, 256, 0, stream>>>(hb, n_xa_post + l * nv::D, xr, nv::D);
    }
    for (int sl = from; sl < 6; ++sl) {
        const int l = sl / 3, k = sl % 3;
        if (k == 0) {
            k_rmsnorm<0><<<nv::M, 256, 0, stream>>>(xr, n_mix_pre + l * nv::D, hn, nv::D);
            k_gemm<1><<<dim3(nv::NIN / 64, nv::M / 64), 256, 0, stream>>>(hn, w_in + (size_t)l * nv::D * nv::NIN, z, nv::M, nv::NIN, nv::D, 2 * nv::GW);
            k_gmlp<<<dim3(nv::M / nv::CH, nv::GH), 256, 0, stream>>>(z, g_v + l * nv::GH * nv::HD, w_sp + (size_t)l * nv::GH * nv::CH * nv::CH, b_sp + l * nv::GH * nv::CH, y);
            k_pool<<<dim3(nv::M / 64, nv::PG), 256, 0, stream>>>(z, w_pool + (size_t)l * nv::PG * 128 * 128, s_pool + l * nv::PW, y);
            k_conv<<<nv::M, 512, 0, stream>>>(z, w_dw + (size_t)l * nv::CK * nv::CW, b_dw + l * nv::CW, cln_g + l * nv::CW, cln_b + l * nv::CW, y);
            k_gemm<0><<<dim3(nv::D / 64, nv::M / 64), 256, 0, stream>>>(y, w_out + (size_t)l * nv::D * nv::D, hb, nv::M, nv::D, nv::D, 0);
            k_rmsnorm<1><<<nv::M, 256, 0, stream>>>(hb, n_mix_post + l * nv::D, xr, nv::D);
        } else if (k == 1) {
            k_rmsnorm<0><<<nv::M, 256, 0, stream>>>(xr, n_xa_pre + l * nv::D, hn, nv::D);
            k_rmsnorm<0><<<nv::MM, 256, 0, stream>>>(mem, n_mem + l * nv::D, mn, nv::D);
            k_gemm<0><<<dim3(nv::D / 64, nv::M / 64), 256, 0, stream>>>(hn, w_q + (size_t)l * nv::D * nv::D, q, nv::M, nv::D, nv::D, 0);
            k_gemm<0><<<dim3(nv::D / 64, nv::MM / 64), 256, 0, stream>>>(mn, w_k + (size_t)l * nv::D * nv::D, kk, nv::MM, nv::D, nv::D, 0);
            k_gemm<0><<<dim3(nv::D / 64, nv::MM / 64), 256, 0, stream>>>(mn, w_v + (size_t)l * nv::D * nv::D, vv, nv::MM, nv::D, nv::D, 0);
            k_attn<<<dim3(nv::M, nv::XH), 256, 0, stream>>>(q, kk, vv, o);
            k_gemm<0><<<dim3(nv::D / 64, nv::M / 64), 256, 0, stream>>>(o, w_o + (size_t)l * nv::D * nv::D, hb, nv::M, nv::D, nv::D, 0);
            k_rmsnorm<1><<<nv::M, 256, 0, stream>>>(hb, n_xa_post + l * nv::D, xr, nv::D);
        } else {
            k_rmsnorm<0><<<nv::M, 256, 0, stream>>>(xr, n_ffn_pre + l * nv::D, hn, nv::D);
            k_gemm<2><<<dim3(nv::FF / 64, nv::M / 64), 256, 0, stream>>>(hn, w_up + (size_t)l * nv::D * nv::FF, up, nv::M, nv::FF, nv::D, 0);
            k_gemm<0><<<dim3(nv::D / 64, nv::M / 64), 256, 0, stream>>>(up, w_down + (size_t)l * nv::FF * nv::D, hb, nv::M, nv::D, nv::FF, 0);
            k_rmsnorm<1><<<nv::M, 256, 0, stream>>>(hb, n_ffn_post + l * nv::D, xr, nv::D);
        }
    }
}
#endif

extern "C" void kernel_launch(void* const* d_in, const int* in_sizes, int n_in, void* d_out, int out_size, void* d_ws, size_t ws_size, hipStream_t stream) {
    static int grid = 0;
    if (grid == 0) {
        if (n_in != 26 || in_sizes[0] != M * D || out_size != M * D || ws_size < WS_END) { fprintf(stderr, "kernel_launch: unexpected shapes (n_in %d, in0 %d, out %d, ws %zu < %zu); nothing launched\n", n_in, n_in > 0 ? in_sizes[0] : -1, out_size, ws_size, (size_t)WS_END); grid = -1; return; }
        int dev = 0, cus = 0, per_cu = 0;
        if (hipGetDevice(&dev) != hipSuccess || hipDeviceGetAttribute(&cus, hipDeviceAttributeMultiprocessorCount, dev) != hipSuccess) { grid = -1; return; }
        if (hipFuncSetAttribute((const void*)mega_fwd, hipFuncAttributeMaxDynamicSharedMemorySize, LDS_BYTES) != hipSuccess) { fprintf(stderr, "kernel_launch: hipFuncSetAttribute failed\n"); grid = -1; return; }
        if (hipOccupancyMaxActiveBlocksPerMultiprocessor(&per_cu, (const void*)mega_fwd, NWAVES * 64, LDS_BYTES) != hipSuccess || per_cu < 1) { fprintf(stderr, "kernel_launch: occupancy query says %d blocks per CU\n", per_cu); per_cu = 1; }
        (void)hipGetLastError();
        grid = cus * 1;
    }
    if (grid < 0) return;
    if (hipMemsetAsync((char*)d_ws + WS_CTL, 0, CTL_ZERO_BYTES, stream) != hipSuccess) { fprintf(stderr, "kernel_launch: memset failed\n"); return; }
    Args a{};
    for (int i = 0; i < 26; ++i) a.in[i] = (const float*)d_in[i];
    a.out = (float*)d_out; a.ws = (unsigned char*)d_ws;
    a.rep = PROBE_REP;
    { const int stops[7] = {1, 5, 8, 11, 15, 18, 1000}; a.stop = stops[DBG_CUT]; }
#if DBG_CUT < 6
    if (DBG_MODE == 1) a.stop = 2; if (DBG_MODE == 2 || DBG_MODE >= 5) a.stop = 3; if (DBG_MODE == 3) a.stop = 6; if (DBG_MODE == 4) a.stop = 8;
#endif
    void* kargs[] = {&a};
    hipError_t e = hipLaunchCooperativeKernel((const void*)mega_fwd, dim3(grid), dim3(NWAVES * 64), kargs, LDS_BYTES, stream);
    if (e != hipSuccess) fprintf(stderr, "kernel_launch: cooperative launch failed: %s (grid %d)\n", hipGetErrorString(e), grid);
#if DBG_CUT < 6
    naive_from(d_in, d_out, d_ws, stream, DBG_CUT);
#endif
}
```

```cpp
#include <hip/hip_runtime.h>
#include <cstdio>
#include <cstdint>

#define LAS __attribute__((address_space(3)))
#define GAS __attribute__((address_space(1)))
typedef unsigned short bf16_t;
typedef short bf16x8 __attribute__((ext_vector_type(8)));
typedef float f32x4 __attribute__((ext_vector_type(4)));
typedef float f32x2 __attribute__((ext_vector_type(2)));
typedef unsigned u32x4 __attribute__((ext_vector_type(4)));
typedef unsigned u32x2 __attribute__((ext_vector_type(2)));

constexpr int D = 2048, NB = 4, SEQ = 2048, NL = 2, MEM = 256, GW = 1024, PW = 512, CW = 512, NIN = 3584, GH = 8, HD = 128, CH = 128, PG = 4, CK = 31, XH = 4, XD = 512, FF = 8192;
constexpr int M = NB * SEQ, MM = NB * MEM;
constexpr float RMS_EPS = 1e-6f, LN_EPS = 1e-5f;

constexpr size_t MiB = 1u << 20;
constexpr size_t WS_CTL = 0, CTL_ZERO_BYTES = 32 * 1024; constexpr int CW_XCC = 7680;
constexpr size_t WS_WPT = 1 * MiB, WS_WSM = 1 * MiB + 256 * 1024;
constexpr size_t WS_W = 2 * MiB, W_LAYER = 118 * MiB;
constexpr size_t WO_IN = 0, WO_OUT = 14 * MiB, WO_Q = 22 * MiB, WO_KV = 30 * MiB, WO_O = 46 * MiB, WO_UP = 54 * MiB, WO_DN = 86 * MiB;
constexpr size_t WS_MN = 238 * MiB;
constexpr size_t WS_KB = 246 * MiB, WS_VB = 250 * MiB, WS_VT = WS_VB;
constexpr size_t WS_XN = 254 * MiB;
constexpr size_t WS_HB = 286 * MiB;
constexpr size_t WS_BIG = 350 * MiB;
constexpr size_t BO_Z = 0, BO_Y = 56 * MiB, BO_Q = 0, BO_P = 32 * MiB, BO_O = 64 * MiB, BO_UP = 0;
constexpr size_t BO_GT = 0, BO_UT = 16 * MiB;
constexpr size_t WS_XH = 478 * MiB;
constexpr size_t WS_END = 510 * MiB;
constexpr int CW_BAR = 4096;

constexpr int RING_BYTES = 131072, LDSCTL_OFF = RING_BYTES, MISC_OFF = LDSCTL_OFF + 320, LDS_BYTES = 147456;
constexpr int NWAVES = 8;

#define LDS_WAIT() asm volatile("s_waitcnt lgkmcnt(0)" ::: "memory")
#define VM_WAIT() asm volatile("s_waitcnt vmcnt(0)" ::: "memory")
#define RLX_AGENT __ATOMIC_RELAXED, __HIP_MEMORY_SCOPE_AGENT

__device__ __forceinline__ unsigned cvt_pk_bf16(float lo, float hi) { unsigned r; asm volatile("v_cvt_pk_bf16_f32 %0, %1, %2" : "=v"(r) : "v"(lo), "v"(hi)); return r; }
__device__ __forceinline__ float bf_lo(unsigned w) { return __builtin_bit_cast(float, w << 16); }
__device__ __forceinline__ float bf_hi(unsigned w) { return __builtin_bit_cast(float, w & 0xffff0000u); }
typedef _Float16 f16x2 __attribute__((ext_vector_type(2)));
__device__ __forceinline__ unsigned pk_f16(float a, float b) { f16x2 v; v[0] = (_Float16)a; v[1] = (_Float16)b; return __builtin_bit_cast(unsigned, v); }
__device__ __forceinline__ f32x2 unpk_f16(unsigned w) { const f16x2 v = __builtin_bit_cast(f16x2, w); const _Float16 a = v[0], b = v[1]; return (f32x2){(float)a, (float)b}; }
__device__ __forceinline__ float fast_sigmoid(float x) { return __builtin_amdgcn_rcpf(1.f + __builtin_amdgcn_exp2f(-1.44269504089f * x)); }
__device__ __forceinline__ float gelu_tanh(float x) { const float u = 0.7978845608028654f * (x + 0.044715f * x * x * x); return x * fast_sigmoid(2.f * u); }
__device__ __forceinline__ int opaque_s(int v) { asm volatile("" : "+s"(v)); return v; }
__device__ __forceinline__ int fresh_tid() { int t = threadIdx.x; asm volatile("" : "+v"(t)); return t; }
template <int CTRL> __device__ __forceinline__ float dppf(float v) { return __builtin_bit_cast(float, __builtin_amdgcn_update_dpp(0, __builtin_bit_cast(int, v), CTRL, 0xf, 0xf, true)); }
__device__ __forceinline__ float lx1(float v) { return dppf<0xB1>(v); }
__device__ __forceinline__ float lx2(float v) { return dppf<0x4E>(v); }
__device__ __forceinline__ float lx16(float v) { return __builtin_bit_cast(float, __builtin_amdgcn_ds_swizzle(__builtin_bit_cast(int, v), 0x401F)); }
__device__ __forceinline__ void halves32(float v, float& lo, float& hi) {
    const unsigned u = __builtin_bit_cast(unsigned, v); auto r = __builtin_amdgcn_permlane32_swap(u, u, false, false);
    const unsigned r0 = r[0], r1 = r[1];
    lo = __builtin_bit_cast(float, r0); hi = __builtin_bit_cast(float, r1); }
__device__ __forceinline__ float sum_x32(float v) { float a, b; halves32(v, a, b); return a + b; }
__device__ __forceinline__ float max_x32(float v) { float a, b; halves32(v, a, b); return fmaxf(a, b); }
__device__ __forceinline__ float wave_sum(float v) {
    v += lx1(v); v += lx2(v); v += dppf<0x141>(v)  ; v += dppf<0x140>(v)  ; v += lx16(v); return sum_x32(v);
}

#define XB_TMO      128
#define XB_XCNT(j)  (256  + 64 * (j))
#define XB_XSUB(j)  (1280 + 64 * (j))
#define XB_XGEN(j)  (2304 + 64 * (j))
#define XB_TOP      3328
#define XB_TOPGEN   3392
#define XCD_BAR_WORDS 3456
#define XB_SPIN_CAP (1u << 18)
__device__ __forceinline__ unsigned xb_ld(unsigned* p)              { return __hip_atomic_load(p, __ATOMIC_RELAXED, __HIP_MEMORY_SCOPE_AGENT); }
__device__ __forceinline__ unsigned xb_add(unsigned* p, unsigned v) { return __hip_atomic_fetch_add(p, v, __ATOMIC_RELAXED, __HIP_MEMORY_SCOPE_AGENT); }
__device__ __forceinline__ unsigned xb_xcc_id() { return (unsigned)__builtin_amdgcn_s_getreg((3 << 11) | 20) & 0xFu; }
#define XB_SPIN(cond, bar) do { unsigned _sp = 0; while (cond) { __builtin_amdgcn_s_sleep(1); \
    if ((++_sp & 255u) == 0u) { if (xb_ld(&(bar)[XB_TMO])) break; if (_sp > XB_SPIN_CAP) { atomicAdd(&(bar)[XB_TMO], 1u); break; } } } } while (0)
struct XcdBarrier { unsigned* bar; unsigned x; volatile LAS unsigned* st; };
__device__ __forceinline__ XcdBarrier xcd_barrier_post(unsigned* bar, volatile LAS unsigned* st) {
    XcdBarrier b; b.bar = bar; b.x = xb_xcc_id(); b.st = st;
    if (threadIdx.x == 0) (void)xb_add(&bar[XB_XCNT(b.x)], 1u);
    return b;
}
__device__ __forceinline__ void xcd_barrier_complete(unsigned* bar, unsigned x, unsigned& nloc, unsigned& nx) {
    const unsigned G = gridDim.x * gridDim.y * gridDim.z;
    unsigned sum, cnt, mine, sp = 0u;
    for (;;) {
        sum = 0u; cnt = 0u; mine = 0u;
#pragma unroll
        for (unsigned j = 0; j < 16; ++j) { const unsigned c = xb_ld(&bar[XB_XCNT(j)]); sum += c; cnt += (c > 0u) ? 1u : 0u; mine = (j == x) ? c : mine; }
        if (sum == G) break;
        __builtin_amdgcn_s_sleep(1);
        if ((++sp & 255u) == 0u) { if (xb_ld(&bar[XB_TMO])) break; if (sp > XB_SPIN_CAP) { atomicAdd(&bar[XB_TMO], 1u); break; } }
    }
    nloc = mine > 0u ? mine : 1u; nx = cnt > 0u ? cnt : 1u;
}
__device__ __forceinline__ void xcd_barrier_t0(const XcdBarrier& b, bool no_wb) {
    unsigned* bar = b.bar; asm volatile("" : "+s"(bar));
    __builtin_amdgcn_s_waitcnt(0);
    unsigned nloc = b.st[0], nx = b.st[1]; unsigned bx = b.x; asm volatile("" : "+s"(bx));
    if (nloc == 0u) { xcd_barrier_complete(bar, bx, nloc, nx); b.st[0] = nloc; b.st[1] = nx; }
    const unsigned old = xb_add(&bar[XB_XSUB(bx)], 1u);
    const unsigned gen = old / nloc;
    if (old + 1u == (gen + 1u) * nloc) {
        if (!no_wb) __builtin_amdgcn_fence(__ATOMIC_RELEASE, "agent");
        asm volatile("s_waitcnt vmcnt(0)" ::: "memory");
        const unsigned og = xb_add(&bar[XB_TOP], 1u);
        const unsigned tg = og / nx;
        if (og + 1u == (tg + 1u) * nx) xb_add(&bar[XB_TOPGEN], 1u);
        else XB_SPIN(xb_ld(&bar[XB_TOPGEN]) == tg, bar);
        __builtin_amdgcn_fence(__ATOMIC_ACQUIRE, "agent");
        xb_add(&bar[XB_XGEN(bx)], 1u);
        asm volatile("s_waitcnt vmcnt(0)" ::: "memory");
    } else {
        XB_SPIN(xb_ld(&bar[XB_XGEN(bx)]) == gen, bar);
        __builtin_amdgcn_fence(__ATOMIC_ACQUIRE, "agent");
        asm volatile("s_waitcnt vmcnt(0)" ::: "memory");
    }
}
__device__ __forceinline__ void xcd_barrier(const XcdBarrier& b, bool no_wb = false) {
    asm volatile("s_waitcnt vmcnt(0)" ::: "memory");
    __syncthreads();
    if (threadIdx.x == 0) xcd_barrier_t0(b, no_wb);
    __syncthreads();
}

namespace pg8 {
constexpr int BM = 256, BK = 64, HALF = 128, HTB = HALF * BK * 2, STAGE_BYTES = 8 * HTB, NXCD = 8, WGM = 8;
__host__ __device__ __forceinline__ int lds_byte(int r, int c) { const int st = (r >> 4) * 2 + (c >> 5), rr = r & 15, cc = c & 31, ob = rr * 64 + cc * 2; return st * 1024 + (ob ^ (((ob >> 9) & 1) << 5)); }
__host__ __device__ __forceinline__ void stage_rc(int b, int& R, int& C) { const int st = b / 1024, sb = b % 1024, swz = sb ^ (((sb >> 9) & 1) << 5); R = (st >> 1) * 16 + swz / 64; C = (st & 1) * 32 + (swz % 64) / 2; }
__host__ __device__ __forceinline__ int perm32(int rho) { const int n = rho >> 4, i = rho & 15; return 8 * (i >> 2) + 4 * n + (i & 3); }

struct Unit { const char* A; const char* B; void* O; int ldo, pm, pn, flag, nt; };

__device__ __forceinline__ void tile_order(int L, int nM, int nN, int& pm, int& pn) {
    const int nwg = nM * nN; int wgid = L; { const int q = nwg / NXCD, r = nwg % NXCD, xcd = wgid % NXCD, off = wgid / NXCD; wgid = (xcd < r ? xcd * (q + 1) : r * (q + 1) + (xcd - r) * q) + off; }
    const int nig = WGM * nN, gid = wgid / nig, fm = gid * WGM, gsz = (nM - fm) < WGM ? (nM - fm) : WGM;
    pm = fm + ((wgid % nig) % gsz); pn = (wgid % nig) / gsz;
}

struct EpiF32 {
    static constexpr bool PERM = false, AFTER_DRAIN = false;
    __device__ __forceinline__ void operator()(const f32x4 (&acc)[2][2][4][2], const Unit& u, int wr, int wc, int fr, int fq) const {
        { const int t_ = fresh_tid(); fr = t_ & 15; fq = (t_ >> 4) & 3; }
        const int row0 = u.pm * BM + wr * 64 + fr, col0 = u.pn * BM + wc * 32 + 4 * fq; float* C = (float*)u.O;
#pragma unroll
        for (int ai = 0; ai < 2; ++ai)
#pragma unroll
            for (int m = 0; m < 4; ++m) { float* rowp = C + (size_t)(row0 + ai * HALF + m * 16) * u.ldo + col0;
#pragma unroll
                for (int bj = 0; bj < 2; ++bj)
#pragma unroll
                    for (int n = 0; n < 2; ++n) *(f32x4*)(rowp + bj * HALF + n * 16) = acc[ai][bj][m][n]; }
    }
};
template <int ACT> struct EpiBf16 {
    static constexpr bool PERM = true, AFTER_DRAIN = false;
    __device__ __forceinline__ void operator()(const f32x4 (&acc)[2][2][4][2], const Unit& u, int wr, int wc, int fr, int fq) const {
        { const int t_ = fresh_tid(); fr = t_ & 15; fq = (t_ >> 4) & 3; }
        const int row0 = u.pm * BM + wr * 64 + fr, col0 = u.pn * BM + wc * 32 + 8 * fq; bf16_t* base = (bf16_t*)u.O;
        const bool act1 = (ACT == 1) && (u.flag != 0);
#pragma unroll
        for (int ai = 0; ai < 2; ++ai)
#pragma unroll
            for (int m = 0; m < 4; ++m) { bf16_t* rowp = base + (size_t)(row0 + ai * HALF + m * 16) * u.ldo + col0;
#pragma unroll
                for (int bj = 0; bj < 2; ++bj) { f32x4 v0 = acc[ai][bj][m][0], v1 = acc[ai][bj][m][1];
                    if (ACT == 1) { if (act1) {
#pragma unroll
                        for (int e = 0; e < 4; ++e) { v0[e] = gelu_tanh(v0[e]); v1[e] = gelu_tanh(v1[e]); } } }
                    if (ACT == 2) {
#pragma unroll
                        for (int e = 0; e < 4; ++e) { const float a = fmaxf(v0[e], 0.f), b = fmaxf(v1[e], 0.f); v0[e] = a * a; v1[e] = b * b; } }
                    u32x4 w; w.x = cvt_pk_bf16(v0[0], v0[1]); w.y = cvt_pk_bf16(v0[2], v0[3]); w.z = cvt_pk_bf16(v1[0], v1[1]); w.w = cvt_pk_bf16(v1[2], v1[3]);
                    *(u32x4*)(rowp + bj * HALF) = w; } }
    }
};
struct EpiSoftmax {
    static constexpr bool PERM = true, AFTER_DRAIN = true;
    float scale_log2e;
    __device__ __forceinline__ void fused(f32x4 (&acc)[2][2][4][2], const Unit& u, int wr, int wc, int fr, int fq, LAS unsigned char* lds, int wid, int lane) const {
        LAS f32x2* P = (LAS f32x2*)lds;
#pragma unroll
        for (int ai = 0; ai < 2; ++ai)
#pragma unroll
            for (int m = 0; m < 4; ++m) {
                float mx = -3.0e38f;
#pragma unroll
                for (int bj = 0; bj < 2; ++bj)
#pragma unroll
                    for (int n = 0; n < 2; ++n) { const f32x4 x = acc[ai][bj][m][n]; mx = fmaxf(mx, fmaxf(fmaxf(x[0], x[1]), fmaxf(x[2], x[3]))); }
                mx = fmaxf(mx, lx16(mx)); mx = max_x32(mx);
                float s = 0.f;
#pragma unroll
                for (int bj = 0; bj < 2; ++bj)
#pragma unroll
                    for (int n = 0; n < 2; ++n) { f32x4 x = acc[ai][bj][m][n];
#pragma unroll
                        for (int e = 0; e < 4; ++e) { x[e] = __builtin_amdgcn_exp2f((x[e] - mx) * scale_log2e); s += x[e]; }
                        acc[ai][bj][m][n] = x; }
                s += lx16(s); s = sum_x32(s);
                if (fq == 0) P[(ai * HALF + wr * 64 + m * 16 + fr) * 4 + wc] = (f32x2){mx, s};
            }
        asm volatile("s_waitcnt lgkmcnt(0)" ::: "memory"); __builtin_amdgcn_s_barrier(); asm volatile("" ::: "memory");
        const int row0 = u.pm * BM + wr * 64 + fr, col0 = u.pn * BM + wc * 32 + 8 * fq; bf16_t* base = (bf16_t*)u.O;
#pragma unroll
        for (int ai = 0; ai < 2; ++ai)
#pragma unroll
            for (int m = 0; m < 4; ++m) {
                const int r = ai * HALF + wr * 64 + m * 16 + fr;
                const f32x2 a = P[r * 4 + 0], b = P[r * 4 + 1], c = P[r * 4 + 2], d = P[r * 4 + 3];
                const float mt = fmaxf(fmaxf(a.x, b.x), fmaxf(c.x, d.x));
                const float ea = __builtin_amdgcn_exp2f((a.x - mt) * scale_log2e), eb = __builtin_amdgcn_exp2f((b.x - mt) * scale_log2e), ec = __builtin_amdgcn_exp2f((c.x - mt) * scale_log2e), ed = __builtin_amdgcn_exp2f((d.x - mt) * scale_log2e);
                const float tot = a.y * ea + b.y * eb + c.y * ec + d.y * ed;
                const float mine = (wc == 0 ? ea : wc == 1 ? eb : wc == 2 ? ec : ed) / tot;
                bf16_t* rowp = base + (size_t)(row0 + ai * HALF + m * 16) * u.ldo + col0;
#pragma unroll
                for (int bj = 0; bj < 2; ++bj) { const f32x4 v0 = acc[ai][bj][m][0] * mine, v1 = acc[ai][bj][m][1] * mine;
                    u32x4 w; w.x = cvt_pk_bf16(v0[0], v0[1]); w.y = cvt_pk_bf16(v0[2], v0[3]); w.z = cvt_pk_bf16(v1[0], v1[1]); w.w = cvt_pk_bf16(v1[2], v1[3]);
                    *(u32x4*)(rowp + bj * HALF) = w; }
            }
    }
};

template <class Epi, class Sched>
__device__ __forceinline__ void gemm_phase(LAS unsigned char* lds, const int lda, const int ldb, const Sched& S, const Epi& E) {
    const int tid = fresh_tid(), wid = __builtin_amdgcn_readfirstlane(tid >> 6), lane = tid & 63, wr = wid >> 2, wc = wid & 3, fr = lane & 15, fq = lane >> 4;
    unsigned voffA[2], voffB[2];
#pragma unroll
    for (int i = 0; i < 2; ++i) { int R, C; stage_rc(tid * 16 + i * 8192, R, C); const int Rb = Epi::PERM ? ((R & ~31) + perm32(R & 31)) : R;
        voffA[i] = (unsigned)(R * lda + C) * 2u; voffB[i] = (unsigned)(Rb * ldb + C) * 2u; }
    const size_t kstep = (size_t)(BK * 2);
    const size_t hstepA = (size_t)HALF * lda * 2, hstepB = (size_t)HALF * ldb * 2;
    const unsigned ldsw = (unsigned)wid * 1024u;
    const int aoff = lds_byte(wr * 64 + fr, fq * 8), boff = lds_byte(wc * 32 + fr, fq * 8);
#define PG8_SA(b, h) (((b) * 2 + (h)) * HTB)
#define PG8_SB(b, h) ((4 + (b) * 2 + (h)) * HTB)
#define PG8_STAGE(bufoff, gbase, voff) do { _Pragma("unroll") for (int _i = 0; _i < 2; ++_i) \
        __builtin_amdgcn_global_load_lds((const unsigned*)((const char*)(gbase) + (voff)[_i]), (LAS unsigned*)(lds + (bufoff) + ldsw + _i * 8192), 16, 0, 0); } while (0)
#define PG8_LDA(dst, b, h) do { _Pragma("unroll") for (int m = 0; m < 4; ++m) _Pragma("unroll") for (int k = 0; k < 2; ++k) dst[m][k] = *(const LAS bf16x8*)(lds + PG8_SA(b, h) + aoff + m * 2048 + k * 1024); } while (0)
#define PG8_LDB(dst, b, h) do { _Pragma("unroll") for (int n = 0; n < 2; ++n) _Pragma("unroll") for (int k = 0; k < 2; ++k) dst[n][k] = *(const LAS bf16x8*)(lds + PG8_SB(b, h) + boff + n * 2048 + k * 1024); } while (0)
#define PG8_MMA(ai, bj, At, Bt) do { __builtin_amdgcn_s_setprio(1); _Pragma("unroll") for (int m = 0; m < 4; ++m) _Pragma("unroll") for (int n = 0; n < 2; ++n) _Pragma("unroll") for (int k = 0; k < 2; ++k) \
        acc[ai][bj][m][n] = __builtin_amdgcn_mfma_f32_16x16x32_bf16(Bt[n][k], At[m][k], acc[ai][bj][m][n], 0, 0, 0); __builtin_amdgcn_s_setprio(0); } while (0)
#define PG8_WAIT_V(n) asm volatile("s_waitcnt vmcnt(" #n ")" ::: "memory")
#define PG8_WAIT_L(n) asm volatile("s_waitcnt lgkmcnt(" #n ")" ::: "memory")
#define PG8_BAR __builtin_amdgcn_s_barrier()
#define PG8_SCHED __builtin_amdgcn_sched_barrier(0)
    Unit cur, nxt; int ui = 0;
    if (!S.next(0, cur)) return;
    f32x4 acc[2][2][4][2];
#pragma unroll
    for (int a = 0; a < 2; ++a)
#pragma unroll
        for (int b = 0; b < 2; ++b)
#pragma unroll
            for (int m = 0; m < 4; ++m)
#pragma unroll
                for (int n = 0; n < 2; ++n) acc[a][b][m][n] = (f32x4){0.f, 0.f, 0.f, 0.f};
    bf16x8 At[4][2], B0[2][2], B1[2][2];
    const char* cA = cur.A; const char* cB = cur.B;
    PG8_STAGE(PG8_SB(0, 0), cB, voffB); PG8_STAGE(PG8_SB(0, 1), cB + hstepB, voffB); PG8_STAGE(PG8_SA(0, 0), cA, voffA); PG8_STAGE(PG8_SA(0, 1), cA + hstepA, voffA);
    if (wr == 1) PG8_BAR;
    PG8_WAIT_V(2); PG8_BAR;
    PG8_STAGE(PG8_SB(1, 0), cB + kstep, voffB); PG8_STAGE(PG8_SA(1, 0), cA + kstep, voffA); PG8_STAGE(PG8_SB(1, 1), cB + hstepB + kstep, voffB);
    PG8_WAIT_V(6); PG8_BAR;
    for (;;) {
        const bool has_next = S.next(ui + 1, nxt);
        const char* nA = has_next ? nxt.A : cA; const char* nB = has_next ? nxt.B : cB;
        const int nt = cur.nt;
        for (int t = 0; t < nt; t += 2) {
            const bool last = (t == nt - 2);
            const char* a1 = cA + (size_t)(t + 1) * kstep;
            const char* a2 = last ? nA : cA + (size_t)(t + 2) * kstep; const char* b2 = last ? nB : cB + (size_t)(t + 2) * kstep;
            const char* a3 = a2 + kstep; const char* b3 = b2 + kstep;
            PG8_LDB(B0, 0, 0); PG8_LDB(B1, 0, 1); PG8_SCHED; PG8_LDA(At, 0, 0); PG8_STAGE(PG8_SA(1, 1), a1 + hstepA, voffA);
            PG8_WAIT_V(8); PG8_WAIT_L(0); PG8_BAR; PG8_MMA(0, 0, At, B0); PG8_MMA(0, 1, At, B1); PG8_BAR; PG8_SCHED;
            PG8_LDA(At, 0, 1); PG8_STAGE(PG8_SB(0, 0), b2, voffB); PG8_STAGE(PG8_SB(0, 1), b2 + hstepB, voffB); PG8_STAGE(PG8_SA(0, 0), a2, voffA);
            PG8_WAIT_V(8); PG8_WAIT_L(0); PG8_BAR; PG8_MMA(1, 0, At, B0); PG8_MMA(1, 1, At, B1); PG8_BAR; PG8_SCHED;
            PG8_LDB(B0, 1, 0); PG8_LDB(B1, 1, 1); PG8_SCHED; PG8_LDA(At, 1, 0); PG8_STAGE(PG8_SA(0, 1), a2 + hstepA, voffA);
            PG8_WAIT_V(8); PG8_WAIT_L(0); PG8_BAR; PG8_MMA(0, 0, At, B0); PG8_MMA(0, 1, At, B1); PG8_BAR; PG8_SCHED;
            PG8_LDA(At, 1, 1); PG8_STAGE(PG8_SB(1, 0), b3, voffB); PG8_STAGE(PG8_SB(1, 1), b3 + hstepB, voffB); PG8_STAGE(PG8_SA(1, 0), a3, voffA);
            PG8_WAIT_V(8); PG8_WAIT_L(0); PG8_BAR; PG8_MMA(1, 0, At, B0); PG8_MMA(1, 1, At, B1); PG8_BAR; PG8_SCHED;
        }
        if (wr == 0) PG8_BAR;
        if constexpr (!Epi::AFTER_DRAIN) { E(acc, cur, wr, wc, fr, fq); }
        if (!has_next) break;
#pragma unroll
        for (int a = 0; a < 2; ++a)
#pragma unroll
            for (int b = 0; b < 2; ++b)
#pragma unroll
                for (int m = 0; m < 4; ++m)
#pragma unroll
                    for (int n = 0; n < 2; ++n) acc[a][b][m][n] = (f32x4){0.f, 0.f, 0.f, 0.f};
        cur = nxt; cA = nA; cB = nB; ++ui;
        if (wr == 1) PG8_BAR;
    }
    PG8_WAIT_V(0);
    PG8_BAR;
    if constexpr (Epi::AFTER_DRAIN) { E.fused(acc, cur, wr, wc, fr, fq, lds, wid, lane); }
#undef PG8_SA
#undef PG8_SB
#undef PG8_STAGE
#undef PG8_LDA
#undef PG8_LDB
#undef PG8_MMA
#undef PG8_WAIT_V
#undef PG8_WAIT_L
#undef PG8_BAR
#undef PG8_SCHED
}
}

template <int LDA, int LDB, int LDO, int NM, int NN, int KD> struct SchedPlain {
    const char* A; const char* B; void* O; int G, c, xg;
    __device__ __forceinline__ bool next(int i, pg8::Unit& u) const {
        int pm, pn;
        if (xg >= 0) { const int Lp = i * 32 + c; if (Lp >= 4 * NN) return false; pm = 4 * xg + (Lp & 3); pn = Lp >> 2; }
        else { const int L = i * G + c; if (L >= NM * NN) return false; pg8::tile_order(L, NM, NN, pm, pn); }
        u.A = A + (size_t)pm * 256 * LDA * 2; u.B = B + (size_t)pn * 256 * LDB * 2; u.O = O; u.ldo = LDO; u.pm = pm; u.pn = pn; u.flag = 0; u.nt = KD / 64; return true;
    }
};
struct SchedIn {
    const char* ws; const char* wl; const char* mn; int G, c, xg;
    __device__ __forceinline__ bool next(int i, pg8::Unit& u) const {
        int pm, pn, Lk; bool isz;
        if (xg >= 0) { const int Lp = i * 32 + c; if (Lp >= 64) return false; isz = Lp < 56; pm = 4 * xg + (Lp & 3); pn = Lp >> 2; Lk = xg * 8 + (Lp - 56); }
        else { const int L = i * G + c; if (L >= 512) return false; isz = L < 448; pg8::tile_order(isz ? L : 0, 32, 14, pm, pn); Lk = L - 448; }
        const bool isk = Lk < 32; const int Lv = Lk - 32;
        const int pmk = Lk & 3, pnk = Lk >> 2, pmv = Lv & 3, pnv = Lv >> 2;
        pm = isz ? pm : (isk ? pmk : pmv); pn = isz ? pn : (isk ? pnk : pnv);
        const char* a0 = isz ? ws + WS_XN : mn;
        const char* b0 = isz ? wl + WO_IN : (isk ? wl + WO_KV : wl + WO_KV + (size_t)D * D * 2);
        u.A = a0 + (size_t)pm * 256 * D * 2; u.B = b0 + (size_t)pn * 256 * D * 2;
        u.O = (void*)(isz ? ws + WS_BIG + BO_Z : (isk ? ws + WS_KB : ws + WS_VB)); u.ldo = isz ? NIN : D;
        u.pm = pm; u.pn = pn; u.flag = isz && pn < 8; u.nt = D / 64; return true;
    }
};
struct SchedGU {
    const char* ws; const char* wl; int G, c, xg;
    __device__ __forceinline__ bool next(int i, pg8::Unit& u) const {
        const int L = (xg >= 0) ? i * 256 + xg * 32 + c : i * G + c;
        if (L < 256) { int pm, pn; if (xg >= 0) { pm = 4 * xg + (c & 3); pn = c >> 2; } else pg8::tile_order(L, M / 256, D / 256, pm, pn);
            u.A = ws + WS_BIG + BO_Y + (size_t)pm * 256 * D * 2; u.B = wl + WO_OUT + (size_t)pn * 256 * D * 2; u.O = (void*)(ws + WS_HB); u.ldo = D; u.pm = pm; u.pn = pn; u.flag = 0; u.nt = D / 64; return true; }
        const int L2 = L - 256; if (L2 >= 256) return false;
        const bool isg = L2 < 128; const int j = L2 & 127, bh = j >> 3, t = j & 7, b = bh >> 2, h = bh & 3;
        const char* kv = ws + (isg ? WS_KB : WS_VB) + ((size_t)(b * MEM) * D + h * XD) * 2;
        const char* w = wl + (isg ? WO_Q : WO_O) + ((size_t)(t * 256) * D + h * XD) * 2;
        u.A = isg ? kv : w; u.B = isg ? w : kv;
        u.O = (void*)(isg ? ws + WS_BIG + BO_GT : ws + WS_BIG + BO_UT + (size_t)b * D * (XH * MEM) * 2);
        u.ldo = isg ? D : XH * MEM; u.pm = isg ? bh : t; u.pn = isg ? t : h; u.flag = 0; u.nt = XD / 64; return true;
    }
};
struct SchedS {
    const char* XN; const char* GT; void* P; int G, c, xg;
    __device__ __forceinline__ bool next(int i, pg8::Unit& u) const {
        int b, h, rp;
        if (xg >= 0) { if (i > 0 || c >= 16) return false; const int pm = 4 * xg + (c & 3); h = c >> 2; b = pm >> 3; rp = pm & 7; }
        else { const int L = i * G + c; if (L >= 128) return false; b = L >> 5; h = (L >> 3) & 3; rp = L & 7; }
        u.A = XN + (size_t)(b * SEQ + rp * 256) * D * 2; u.B = GT + (size_t)((b * 4 + h) * 256) * D * 2; u.O = P; u.ldo = XH * MEM; u.pm = b * 8 + rp; u.pn = h; u.flag = 0; u.nt = D / 64; return true;
    }
};
struct SchedO {
    const char* P; const char* UT; void* HB; int G, c, xg;
    __device__ __forceinline__ bool next(int i, pg8::Unit& u) const {
        int pm, pn;
        if (xg >= 0) { if (i > 0) return false; pm = 4 * xg + (c & 3); pn = c >> 2; }
        else { const int L = i * G + c; if (L >= 256) return false; pg8::tile_order(L, 32, 8, pm, pn); }
        const int b = pm >> 3;
        u.A = P + (size_t)pm * 256 * (XH * MEM) * 2; u.B = UT + ((size_t)b * D + pn * 256) * (XH * MEM) * 2; u.O = HB; u.ldo = D; u.pm = pm; u.pn = pn; u.flag = 0; u.nt = (XH * MEM) / 64; return true;
    }
};

struct Frame {
    LAS unsigned char* lds; int tid, lane, wave, vcu, G; int xg; bool local;
    decltype(__builtin_amdgcn_kernarg_segment_ptr()) kp; float* out; unsigned char* ws;
};
__device__ __forceinline__ const float* inp(const Frame& F, int i) { asm volatile("" : "+s"(i)); return (const float*)*(const GAS float* const*)((const char*)F.kp + 8 * i); }

__device__ __forceinline__ void refresh(Frame& F) { F.tid = fresh_tid(); F.lane = F.tid & 63; F.wave = __builtin_amdgcn_readfirstlane(F.tid >> 6); }
constexpr int T_IN = (D / 64) * (NIN / 64), T_SQ = (D / 64) * (D / 64), T_UP = (D / 64) * (FF / 64);
constexpr int T_TR = T_IN + 4 * T_SQ + 2 * T_UP;
constexpr int U_LAYER = T_TR * 2, U_ALL = NL * U_LAYER;
constexpr int U_IDLE_SHARE = 15360;
constexpr int U_PB0 = T_IN * 2, U_PB1 = U_PB0 + 1792;
constexpr int U_WOUT1 = (T_IN + T_SQ) * 2, U_WO0 = (T_IN + 3 * T_SQ) * 2, U_WO1 = U_WO0 + 1792 - (U_WOUT1 - U_PB1);
constexpr int U_IDLE_SHARE_L1 = 16384;
constexpr int U_L1_IN_S0 = 8192;
constexpr int U_EARLY = (T_IN + 4 * T_SQ) * 2;
struct TUnit { const float* src; bf16_t* dst; int N, K; };
__device__ __forceinline__ TUnit p0_unit(const Frame& F, int u) {
    const int g = u >> 3, kt = (u >> 1) & 3, hh = u & 1, l = g / (T_TR / 4); int r = g % (T_TR / 4); unsigned char* wl = F.ws + WS_W + (size_t)l * W_LAYER;
    int idx, K = D, N = D, row_off = 0; size_t wo, lsz = (size_t)D * D;
    if (r < T_IN / 4) { idx = 4; N = NIN; wo = WO_IN; lsz = (size_t)D * NIN; }
    else if ((r -= T_IN / 4) < T_SQ / 4) { idx = 5; wo = WO_OUT; }
    else if ((r -= T_SQ / 4) < T_SQ / 4) { idx = 19; wo = WO_KV; }
    else if ((r -= T_SQ / 4) < T_SQ / 4) { idx = 20; wo = WO_KV; row_off = D; }
    else if ((r -= T_SQ / 4) < T_SQ / 4) { idx = 21; wo = WO_O; }
    else if ((r -= T_SQ / 4) < T_UP / 4) { idx = 24; N = FF; wo = WO_UP; lsz = (size_t)D * FF; }
    else { r -= T_UP / 4; idx = 25; K = FF; wo = WO_DN; lsz = (size_t)D * FF; }
    const int nblk = N / 256, k0 = 64 * (r / nblk), n0 = 256 * (r % nblk) + 64 * kt + 32 * hh;
    TUnit t; t.src = inp(F, idx) + (size_t)l * lsz + (size_t)k0 * N + n0; t.dst = (bf16_t*)(wl + wo) + (size_t)(row_off + n0) * K + k0; t.N = N; t.K = K; return t;
}
__device__ __forceinline__ void p0_unit_dma(const TUnit& t, int lane, LAS unsigned char* buf) {
#pragma unroll
    for (int i = 0; i < 8; ++i)
        __builtin_amdgcn_global_load_lds((const unsigned*)(t.src + (size_t)(8 * i + (lane >> 3)) * t.N + 4 * ((lane & 7) ^ i)), (LAS unsigned*)(buf + i * 1024), 16, 0,   2);
}
__device__ __forceinline__ void p0_unit_out(const TUnit& t, int lane, const LAS float* scr) {
    const int kc = lane & 7;
#pragma unroll
    for (int j = 0; j < 4; ++j) { const int n = (lane >> 3) + 8 * j; const LAS float* s = scr + (8 * kc) * 32 + (n ^ (4 * kc));
        u32x4 o; o.x = cvt_pk_bf16(s[0 * 32], s[1 * 32]); o.y = cvt_pk_bf16(s[2 * 32], s[3 * 32]); o.z = cvt_pk_bf16(s[4 * 32], s[5 * 32]); o.w = cvt_pk_bf16(s[6 * 32], s[7 * 32]);
        *(GAS u32x4*)(t.dst + (size_t)n * t.K + 8 * kc) = o; }
}
__device__ __forceinline__ void p0_convert(Frame& F, int w0, int nw, int lo, int hi) {
    LAS unsigned char* base = F.lds + F.wave * 16384;
    int u = lo + w0; if (u >= hi) return;
    int b = 0;
    TUnit tc = p0_unit(F, u);
    p0_unit_dma(tc, F.lane, base);
    for (; u < hi; u += nw) {
        const bool more = u + nw < hi;
        TUnit tn = tc;
        if (more) { tn = p0_unit(F, u + nw); p0_unit_dma(tn, F.lane, base + (b ^ 1) * 8192); asm volatile("s_waitcnt vmcnt(8)" ::: "memory"); }
        else asm volatile("s_waitcnt vmcnt(0)" ::: "memory");
        p0_unit_out(tc, F.lane, (const LAS float*)(base + b * 8192));
        LDS_WAIT(); asm volatile("" ::: "memory");
        tc = tn; b ^= 1;
    }
}
__device__ __forceinline__ void xcd_barrier_conv(const XcdBarrier& b, bool no_wb, Frame& F, int u0, int uend, int n0 = 1 << 30, int u1 = 0) {
    asm volatile("s_waitcnt vmcnt(0)" ::: "memory");
    __syncthreads();
    refresh(F);
    if (F.wave == 0) { if (F.tid == 0) xcd_barrier_t0(b, no_wb); }
    else { const int v = 7 * (int)blockIdx.x + (F.wave - 1), u = v < n0 ? u0 + v : u1 + (v - n0);
        if (u < uend) { LAS unsigned char* buf = F.lds + F.wave * 16384; const TUnit t = p0_unit(F, u);
            p0_unit_dma(t, F.lane, buf); asm volatile("s_waitcnt vmcnt(0)" ::: "memory");
            p0_unit_out(t, F.lane, (const LAS float*)buf); LDS_WAIT(); asm volatile("" ::: "memory"); } }
    __syncthreads();
}
__device__ __forceinline__ void xcd_barrier_plain(const XcdBarrier& b, bool no_wb, Frame& F, int lq, int c0, int c1) {
    asm volatile("s_waitcnt vmcnt(0)" ::: "memory");
    __syncthreads();
    refresh(F);
    if (F.wave == 0) { if (F.tid == 0) xcd_barrier_t0(b, no_wb); }
    else { const int cb = c0 + (7 * (int)blockIdx.x + (F.wave - 1)) * 64 + F.lane; f32x4 a[3], bq[3];
        const GAS f32x4* src = (const GAS f32x4*)(inp(F, 18) + (size_t)lq * D * D); GAS u32x4* dst = (GAS u32x4*)(F.ws + WS_W + (size_t)lq * W_LAYER + WO_Q);
#pragma unroll
        for (int q = 0; q < 3; ++q) { const int c = cb + q * (1792 * 64); if (c < c1) { a[q] = __builtin_nontemporal_load(src + 2 * c); bq[q] = __builtin_nontemporal_load(src + 2 * c + 1); } }
#pragma unroll
        for (int q = 0; q < 3; ++q) { const int c = cb + q * (1792 * 64); if (c < c1) { u32x4 o; o.x = cvt_pk_bf16(a[q].x, a[q].y); o.y = cvt_pk_bf16(a[q].z, a[q].w); o.z = cvt_pk_bf16(bq[q].x, bq[q].y); o.w = cvt_pk_bf16(bq[q].z, bq[q].w); dst[c] = o; } } }
    __syncthreads();
}
__device__ __forceinline__ void p0_plain(Frame& F, int gw, int ngw, int l0, int l1) {
    for (int c = l0 * (D * D / 8) + gw * 64 + F.lane; c < l1 * (D * D / 8); c += ngw * 64) {
        const int l = c / (D * D / 8), r = c % (D * D / 8);
        const GAS f32x4* sp = (const GAS f32x4*)(inp(F, 18) + (size_t)l * D * D) + 2 * r; const f32x4 a = __builtin_nontemporal_load(sp), bq = __builtin_nontemporal_load(sp + 1);
        u32x4 o; o.x = cvt_pk_bf16(a.x, a.y); o.y = cvt_pk_bf16(a.z, a.w); o.z = cvt_pk_bf16(bq.x, bq.y); o.w = cvt_pk_bf16(bq.z, bq.w);
        ((GAS u32x4*)(F.ws + WS_W + (size_t)l * W_LAYER + WO_Q))[r] = o; }
}
__device__ __forceinline__ void rms_row_to_bf16(const float* xrow, const float* g, bf16_t* orow, float* cp, int lane) {
    const GAS f32x4* xr = (const GAS f32x4*)xrow + lane; f32x4 v[8]; float s = 0.f;
#pragma unroll
    for (int j = 0; j < 8; ++j) { v[j] = xr[64 * j]; s += (v[j].x * v[j].x + v[j].y * v[j].y) + (v[j].z * v[j].z + v[j].w * v[j].w); }
    const float rs = 1.f / sqrtf(wave_sum(s) * (1.f / D) + RMS_EPS);
    if (cp) { GAS f32x4* c4 = (GAS f32x4*)cp + lane;
#pragma unroll
        for (int j = 0; j < 8; ++j) c4[64 * j] = v[j]; }
    const GAS f32x4* g4 = (const GAS f32x4*)g + lane; GAS u32x2* o8 = (GAS u32x2*)orow + lane;
#pragma unroll
    for (int j = 0; j < 8; ++j) { const f32x4 gg = g4[64 * j]; u32x2 w; w.x = cvt_pk_bf16(v[j].x * rs * gg.x, v[j].y * rs * gg.y); w.y = cvt_pk_bf16(v[j].z * rs * gg.z, v[j].w * rs * gg.w); o8[64 * j] = w; }
}
__device__ __forceinline__ void p0_memnorm(Frame& F, int gw, int ngw, int l0, int l1) {
    for (int m = l0 * MM + gw; m < l1 * MM; m += ngw) { const int l = m / MM, r = m % MM;
        rms_row_to_bf16(inp(F, 1) + (size_t)r * D, inp(F, 16) + l * D, (bf16_t*)(F.ws + WS_MN) + (size_t)m * D, nullptr, F.lane); }
}
__device__ __forceinline__ void p0_prologue(Frame& F) {
    refresh(F);
    const int gw = F.vcu * NWAVES + F.wave, NGW = F.G * NWAVES;
    if (F.G == 256) { p0_convert(F, gw, NGW, 0, U_PB0); p0_convert(F, gw, NGW, U_WOUT1, U_WO0); p0_convert(F, gw, NGW, U_WO1, U_EARLY); }
    else for (int l = 0; l < NL; ++l) p0_convert(F, gw, NGW, l * U_LAYER, (l + 1) * U_LAYER);
    p0_plain(F, gw, NGW, 0, (F.G == 256) ? 1 : NL);
    for (int r = gw; r < NL * PG * 128; r += NGW) {
        const float* wp = inp(F, 9) + (size_t)(r >> 7) * 128 * 128 + (r & 127);
        ((GAS unsigned*)(F.ws + WS_WPT))[(size_t)r * 64 + F.lane] = cvt_pk_bf16(wp[(2 * F.lane) * 128], wp[(2 * F.lane + 1) * 128]); }
    for (int r = gw; r < NL * GH * CH; r += NGW) {
        const int t = r & 127; const f32x2 w2 = *(const GAS f32x2*)(inp(F, 7) + (size_t)r * CH + 2 * F.lane);
        ((GAS unsigned*)(F.ws + WS_WSM))[(size_t)r * 64 + F.lane] = cvt_pk_bf16(2 * F.lane <= t ? w2.x : 0.f, 2 * F.lane + 1 <= t ? w2.y : 0.f); }
    p0_memnorm(F, gw, NGW, 0, NL);
    for (int m0 = gw; m0 < M; m0 += 4 * NGW) {
        f32x4 v[4][8];
#pragma unroll
        for (int r = 0; r < 4; ++r) { const int m = m0 + r * NGW; if (m < M) { const GAS f32x4* xr = (const GAS f32x4*)(inp(F, 0) + (size_t)m * D) + F.lane;
#pragma unroll
            for (int j = 0; j < 8; ++j) v[r][j] = xr[64 * j]; } }
#pragma unroll
        for (int r = 0; r < 4; ++r) { const int m = m0 + r * NGW; if (m < M) { float s = 0.f;
#pragma unroll
            for (int j = 0; j < 8; ++j) s += (v[r][j].x * v[r][j].x + v[r][j].y * v[r][j].y) + (v[r][j].z * v[r][j].z + v[r][j].w * v[r][j].w);
            const float ms0 = wave_sum(s) * (1.f / D) + RMS_EPS, rs = 1.f / sqrtf(ms0);
            if (F.lane == 0) ((float*)(F.ws + WS_XH))[m] = sqrtf(ms0);
            const GAS f32x4* g4 = (const GAS f32x4*)inp(F, 2) + F.lane; GAS u32x2* o8 = (GAS u32x2*)((bf16_t*)(F.ws + WS_XN) + (size_t)m * D) + F.lane;
#pragma unroll
            for (int j = 0; j < 8; ++j) { const f32x4 gg = g4[64 * j]; u32x2 w; w.x = cvt_pk_bf16(v[r][j].x * rs * gg.x, v[r][j].y * rs * gg.y); w.y = cvt_pk_bf16(v[r][j].z * rs * gg.z, v[r][j].w * rs * gg.w); o8[64 * j] = w; } } }
    }
}

template <bool IN_F32, bool OUT_F32>
__device__ __forceinline__ void norm_pass(Frame& F, const float* g_post, const float* g_pre, const float* g_prev) {
    refresh(F);
    const int gw = F.vcu * NWAVES + F.wave, NGW = F.G * NWAVES;
    const bf16_t* HB = (const bf16_t*)(F.ws + WS_HB); bf16_t* XN = (bf16_t*)(F.ws + WS_XN); float* RSI = (float*)(F.ws + WS_XH);
    constexpr int NR = IN_F32 ? 2 : 4;
    const int mBeg = (F.xg >= 0) ? F.xg * 1024 + (F.vcu & 31) * NWAVES + F.wave : gw, mStep = (F.xg >= 0) ? 256 : NGW, mEnd = (F.xg >= 0) ? F.xg * 1024 + 1024 : M;
    LAS f32x4* ginv = (LAS f32x4*)F.lds;
    if constexpr (!IN_F32) { const f32x4 g = ((const GAS f32x4*)g_prev)[F.tid]; ginv[F.tid] = (f32x4){1.f / g.x, 1.f / g.y, 1.f / g.z, 1.f / g.w}; LDS_WAIT(); __syncthreads(); }
    for (int m0 = mBeg; m0 < mEnd; m0 += NR * mStep) {
        u32x2 hw[NR][8]; f32x4 xf[IN_F32 ? NR : 1][8]; u32x2 xw[IN_F32 ? 1 : NR][8]; float rsi[NR];
#pragma unroll
        for (int r = 0; r < NR; ++r) { const int m = m0 + r * mStep; rsi[r] = 0.f; if (m < mEnd) {
            const GAS u32x2* hr = (const GAS u32x2*)(HB + (size_t)m * D) + F.lane;
            if constexpr (IN_F32) { const GAS f32x4* xi = (const GAS f32x4*)(inp(F, 0) + (size_t)m * D) + F.lane;
#pragma unroll
                for (int j = 0; j < 8; ++j) xf[IN_F32 ? r : 0][j] = __builtin_nontemporal_load(xi + 64 * j); }
            else { const GAS u32x2* xi = (const GAS u32x2*)(XN + (size_t)m * D) + F.lane; rsi[r] = RSI[m];
#pragma unroll
                for (int j = 0; j < 8; ++j) xw[IN_F32 ? 0 : r][j] = xi[64 * j]; }
#pragma unroll
            for (int j = 0; j < 8; ++j) hw[r][j] = __builtin_nontemporal_load(hr + 64 * j); } }
#pragma unroll
        for (int r = 0; r < NR; ++r) { const int m = m0 + r * mStep; if (m < mEnd) {
            const GAS f32x4* gp = (const GAS f32x4*)g_post + F.lane;
            f32x4 x[8]; float s = 0.f;
#pragma unroll
            for (int j = 0; j < 8; ++j) { const u32x2 w = hw[r][j]; const f32x4 hj = (f32x4){bf_lo(w.x), bf_hi(w.x), bf_lo(w.y), bf_hi(w.y)}; s += (hj.x * hj.x + hj.y * hj.y) + (hj.z * hj.z + hj.w * hj.w); }
            const float rs = 1.f / sqrtf(wave_sum(s) * (1.f / D) + RMS_EPS); float s2 = 0.f;
#pragma unroll
            for (int j = 0; j < 8; ++j) { const f32x4 g = gp[64 * j]; const u32x2 w = hw[r][j]; const f32x4 hj = (f32x4){bf_lo(w.x), bf_hi(w.x), bf_lo(w.y), bf_hi(w.y)};
                if constexpr (IN_F32) x[j] = xf[IN_F32 ? r : 0][j]; else { const u32x2 q = xw[IN_F32 ? 0 : r][j]; x[j] = (f32x4){bf_lo(q.x), bf_hi(q.x), bf_lo(q.y), bf_hi(q.y)} * rsi[r] * ginv[F.lane + 64 * j]; }
                x[j] = x[j] + hj * rs * g;
                if constexpr (OUT_F32) ((GAS f32x4*)(F.out + (size_t)m * D) + F.lane)[64 * j] = x[j];
                s2 += (x[j].x * x[j].x + x[j].y * x[j].y) + (x[j].z * x[j].z + x[j].w * x[j].w); }
            if (g_pre) {
                const float ms = wave_sum(s2) * (1.f / D) + RMS_EPS, rs2 = 1.f / sqrtf(ms);
                if (F.lane == 0) RSI[m] = sqrtf(ms);
                const GAS f32x4* g4 = (const GAS f32x4*)g_pre + F.lane; GAS u32x2* o8 = (GAS u32x2*)(XN + (size_t)m * D) + F.lane;
#pragma unroll
                for (int j = 0; j < 8; ++j) { const f32x4 gg = g4[64 * j]; u32x2 w; w.x = cvt_pk_bf16(x[j].x * rs2 * gg.x, x[j].y * rs2 * gg.y); w.y = cvt_pk_bf16(x[j].z * rs2 * gg.z, x[j].w * rs2 * gg.w); o8[64 * j] = w; }
            } } }
    }
}

constexpr int LDP = 136;
__device__ __forceinline__ void small_mma(const LAS bf16_t* Tm, const LAS bf16_t* Dm, int wave, int fr, int fq, f32x4 (&acc)[8]) {
#pragma unroll
    for (int dt = 0; dt < 8; ++dt) acc[dt] = (f32x4){0.f, 0.f, 0.f, 0.f};
#pragma unroll
    for (int k = 0; k < 4; ++k) {
        const bf16x8 y = *(const LAS bf16x8*)(Tm + (16 * wave + fr) * LDP + 32 * k + 8 * fq);
#pragma unroll
        for (int dt = 0; dt < 8; ++dt) { const bf16x8 x = *(const LAS bf16x8*)(Dm + (32 * (dt >> 1) + 8 * (fr >> 2) + 4 * (dt & 1) + (fr & 3)) * LDP + 32 * k + 8 * fq);
            acc[dt] = __builtin_amdgcn_mfma_f32_16x16x32_bf16(x, y, acc[dt], 0, 0, 0); }
    }
}
__device__ __forceinline__ void gmlp_pair(Frame& F, int l, int pair) {
    refresh(F);
    const int bc = (F.xg >= 0) ? 8 * F.xg + ((pair & 31) >> 3) : pair >> 3, dbc = (F.xg >= 0) ? 4 : 32, h = pair & 7, tid = F.tid;
    LAS bf16_t* Wm = (LAS bf16_t*)F.lds; LAS bf16_t* vT0 = Wm + 128 * LDP; LAS bf16_t* vT1 = vT0 + 128 * LDP;
    const bf16_t* Z = (const bf16_t*)(F.ws + WS_BIG + BO_Z); bf16_t* Y = (bf16_t*)(F.ws + WS_BIG + BO_Y);
    const int t = tid >> 2, q4 = tid & 3;
    const int fr = F.lane & 15, fq = F.lane >> 4;
    const int tt = 16 * F.wave + fr;
    u32x4 uw[2][4];
#pragma unroll
    for (int p2 = 0; p2 < 2; ++p2) { const bf16_t* urow = Z + (size_t)((bc + dbc * p2) * CH + tt) * NIN + h * HD + 8 * fq;
#pragma unroll
        for (int j = 0; j < 4; ++j) uw[p2][j] = *(const GAS u32x4*)(urow + 32 * j); }
    {
        const GAS u32x4* wsrc = (const GAS u32x4*)((const bf16_t*)(F.ws + WS_WSM) + ((size_t)(l * GH + h) * CH + t) * CH + q4 * 32);
#pragma unroll
        for (int j = 0; j < 4; ++j) *(LAS u32x4*)(Wm + t * LDP + q4 * 32 + 8 * j) = wsrc[j];
    }
    {
        const GAS f32x4* gv4 = (const GAS f32x4*)(inp(F, 6) + (l * GH + h) * HD + q4 * 32); float gv[32];
#pragma unroll
        for (int i = 0; i < 8; ++i) { const f32x4 g = gv4[i]; gv[4 * i] = g.x; gv[4 * i + 1] = g.y; gv[4 * i + 2] = g.z; gv[4 * i + 3] = g.w; }
        u32x4 vw[2][4];
#pragma unroll
        for (int p2 = 0; p2 < 2; ++p2) { const GAS u32x4* vsrc = (const GAS u32x4*)(Z + (size_t)((bc + dbc * p2) * CH + t) * NIN + GW + h * HD + q4 * 32);
#pragma unroll
            for (int j = 0; j < 4; ++j) vw[p2][j] = vsrc[j]; }
#pragma unroll
        for (int p2 = 0; p2 < 2; ++p2) { LAS bf16_t* vT = p2 ? vT1 : vT0;
            float v[32]; float sum = 0.f;
#pragma unroll
            for (int j = 0; j < 4; ++j) { const u32x4 w = vw[p2][j];
                v[8 * j + 0] = bf_lo(w.x); v[8 * j + 1] = bf_hi(w.x); v[8 * j + 2] = bf_lo(w.y); v[8 * j + 3] = bf_hi(w.y); v[8 * j + 4] = bf_lo(w.z); v[8 * j + 5] = bf_hi(w.z); v[8 * j + 6] = bf_lo(w.w); v[8 * j + 7] = bf_hi(w.w); }
#pragma unroll
            for (int i = 0; i < 32; ++i) sum += v[i];
            sum += lx1(sum); sum += lx2(sum);
            const float mu = sum * (1.f / HD); float q = 0.f;
#pragma unroll
            for (int i = 0; i < 32; ++i) { v[i] -= mu; q += v[i] * v[i]; }
            q += lx1(q); q += lx2(q);
            const float rs = 1.f / sqrtf(q * (1.f / HD) + LN_EPS);
#pragma unroll
            for (int i = 0; i < 32; i += 2) { const unsigned w = cvt_pk_bf16(v[i] * rs * gv[i], v[i + 1] * rs * gv[i + 1]);
                vT[(q4 * 32 + i) * LDP + t] = (bf16_t)(w & 0xffffu); vT[(q4 * 32 + i + 1) * LDP + t] = (bf16_t)(w >> 16); } }
    }
    __syncthreads();
    f32x4 acc0[8], acc1[8];
#pragma unroll
    for (int dt = 0; dt < 8; ++dt) { acc0[dt] = (f32x4){0.f, 0.f, 0.f, 0.f}; acc1[dt] = (f32x4){0.f, 0.f, 0.f, 0.f}; }
#pragma unroll
    for (int k = 0; k < 4; ++k) {
        const bf16x8 y = *(const LAS bf16x8*)(Wm + (16 * F.wave + fr) * LDP + 32 * k + 8 * fq);
#pragma unroll
        for (int dt = 0; dt < 8; ++dt) { const int drow = (32 * (dt >> 1) + 8 * (fr >> 2) + 4 * (dt & 1) + (fr & 3)) * LDP + 32 * k + 8 * fq;
            acc0[dt] = __builtin_amdgcn_mfma_f32_16x16x32_bf16(*(const LAS bf16x8*)(vT0 + drow), y, acc0[dt], 0, 0, 0);
            acc1[dt] = __builtin_amdgcn_mfma_f32_16x16x32_bf16(*(const LAS bf16x8*)(vT1 + drow), y, acc1[dt], 0, 0, 0); }
    }
    {
        const float bsv = inp(F, 8)[(l * GH + h) * CH + tt];
#pragma unroll
        for (int p2 = 0; p2 < 2; ++p2) { bf16_t* yrow = Y + (size_t)((bc + dbc * p2) * CH + tt) * D + h * HD + 8 * fq;
#pragma unroll
            for (int j = 0; j < 4; ++j) { const f32x4 a = p2 ? acc1[2 * j] : acc0[2 * j], b = p2 ? acc1[2 * j + 1] : acc0[2 * j + 1]; const u32x4 uu = uw[p2][j];
                u32x4 o; o.x = cvt_pk_bf16(bf_lo(uu.x) * (a[0] + bsv), bf_hi(uu.x) * (a[1] + bsv)); o.y = cvt_pk_bf16(bf_lo(uu.y) * (a[2] + bsv), bf_hi(uu.y) * (a[3] + bsv));
                o.z = cvt_pk_bf16(bf_lo(uu.z) * (b[0] + bsv), bf_hi(uu.z) * (b[1] + bsv)); o.w = cvt_pk_bf16(bf_lo(uu.w) * (b[2] + bsv), bf_hi(uu.w) * (b[3] + bsv));
                *(GAS u32x4*)(yrow + 32 * j) = o; } }
    }
    __syncthreads();
}
struct PoolRegs { u32x4 z[5]; u32x4 w[4]; };
__device__ __forceinline__ void pool_load(Frame& F, int l, int unit, PoolRegs& R) {
    refresh(F);
    const int bc = unit >> 2, g = unit & 3, row0 = bc * CH, cseq = bc & 15, tid = F.tid;
    const bf16_t* Z = (const bf16_t*)(F.ws + WS_BIG + BO_Z);
#pragma unroll
    for (int k = 0; k < 5; ++k) { const int ch = tid + 512 * k, i = ch >> 4, c16 = ch & 15; R.z[k] = (u32x4){0u, 0u, 0u, 0u};
        if (ch < 144 * 16 && (cseq > 0 || i >= 16)) R.z[k] = *(const GAS u32x4*)(Z + (size_t)(row0 - 16 + i) * NIN + 2 * GW + g * 128 + c16 * 8); }
    const int d = tid >> 2, q4 = tid & 3; const GAS u32x4* wsrc = (const GAS u32x4*)((const bf16_t*)(F.ws + WS_WPT) + ((size_t)(l * PG + g) * 128 + d) * 128 + q4 * 32);
#pragma unroll
    for (int j = 0; j < 4; ++j) R.w[j] = wsrc[j];
}
__device__ __forceinline__ void pool_unit(Frame& F, int l, int unit, const PoolRegs& R) {
    refresh(F);
    const int bc = unit >> 2, g = unit & 3, row0 = bc * CH, cseq = bc & 15, w = 2 << g, tid = F.tid;
    LAS unsigned* Pt = (LAS unsigned*)F.lds;
    LAS bf16_t* Pl = (LAS bf16_t*)(F.lds + 36864); LAS bf16_t* WpT = Pl + 128 * LDP;
    bf16_t* Y = (bf16_t*)(F.ws + WS_BIG + BO_Y);
#pragma unroll
    for (int k = 0; k < 5; ++k) { const int ch = tid + 512 * k, i = ch >> 4, c16 = ch & 15; if (ch < 144 * 16) *(LAS u32x4*)(Pt + i * 64 + c16 * 4) = R.z[k]; }
    {
        const int d = tid >> 2, q4 = tid & 3;
#pragma unroll
        for (int j = 0; j < 4; ++j) *(LAS u32x4*)(WpT + d * LDP + q4 * 32 + 8 * j) = R.w[j];
    }
    __syncthreads();
    {
        const int cp = tid & 63, tg = tid >> 6, i0 = tg * 16 + 16;
        float s0 = 0.f, s1 = 0.f;
        for (int j = 1; j < w; ++j) { const unsigned d = Pt[(i0 - j) * 64 + cp]; s0 += bf_lo(d); s1 += bf_hi(d); }
#pragma unroll
        for (int tt = 0; tt < 16; ++tt) { const int t = tg * 16 + tt, i = t + 16, pos = cseq * CH + t;
            const unsigned self = Pt[i * 64 + cp]; s0 += bf_lo(self); s1 += bf_hi(self);
            const float inv = 1.f / (float)((pos + 1) < w ? (pos + 1) : w);
            ((LAS unsigned*)Pl)[t * (LDP / 2) + cp] = cvt_pk_bf16(s0 * inv - bf_lo(self), s1 * inv - bf_hi(self));
            const unsigned old = Pt[(i - w + 1) * 64 + cp]; s0 -= bf_lo(old); s1 -= bf_hi(old); }
    }
    __syncthreads();
    const int fr = F.lane & 15, fq = F.lane >> 4;
    f32x4 acc[8];
    small_mma(Pl, WpT, F.wave, fr, fq, acc);
    {
        const int tt = 16 * F.wave + fr; const float* sp = inp(F, 10) + l * PW + g * 128 + 8 * fq; bf16_t* yrow = Y + (size_t)(row0 + tt) * D + GW + g * 128 + 8 * fq;
#pragma unroll
        for (int j = 0; j < 4; ++j) { const f32x4 s0 = *(const GAS f32x4*)(sp + 32 * j), s1 = *(const GAS f32x4*)(sp + 32 * j + 4); const f32x4 a = acc[2 * j], b = acc[2 * j + 1];
            u32x4 o; o.x = cvt_pk_bf16(a[0] * s0.x, a[1] * s0.y); o.y = cvt_pk_bf16(a[2] * s0.z, a[3] * s0.w); o.z = cvt_pk_bf16(b[0] * s1.x, b[1] * s1.y); o.w = cvt_pk_bf16(b[2] * s1.z, b[3] * s1.w);
            *(GAS u32x4*)(yrow + 32 * j) = o; }
    }
    __syncthreads();
}
constexpr int CT = 32, CR = CT + CK - 1;
template <int I> __device__ __forceinline__ void conv_taps(float (&acc)[CT], const float (&wj)[CK], const LAS bf16_t* Hc) {
    if constexpr (I < CR) {
        const float hv = __builtin_bit_cast(float, (unsigned)Hc[I * 512] << 16);
        constexpr int T0 = (I - (CK - 1) > 0) ? I - (CK - 1) : 0, T1 = (I < CT - 1) ? I : CT - 1;
#pragma unroll
        for (int t = T0; t <= T1; ++t) acc[t] += wj[I - t] * hv;
        conv_taps<I + 1>(acc, wj, Hc);
    }
}
constexpr int CONV_NP = CR * 64, CONV_NK = (CONV_NP + 511) / 512;
struct ConvRegs { u32x4 cv[CONV_NK], cg[CONV_NK]; };
__device__ __forceinline__ void conv_load(Frame& F, int unit, ConvRegs& R) {
    refresh(F);
    const int row0 = unit * CT, pos0 = row0 & (SEQ - 1), c = F.tid;
    const bf16_t* Z = (const bf16_t*)(F.ws + WS_BIG + BO_Z);
#pragma unroll
    for (int k = 0; k < CONV_NK; ++k) { const int p = (c + 512 * k < CONV_NP) ? c + 512 * k : c; const int i = p >> 6, grp = p & 63; const bool ok = (pos0 - (CK - 1) + i) >= 0;
        const bf16_t* zr = Z + (size_t)(ok ? row0 - (CK - 1) + i : row0) * NIN + 2 * GW + PW + 8 * grp;
        R.cv[k] = *(const GAS u32x4*)zr; R.cg[k] = *(const GAS u32x4*)(zr + CW); }
}
__device__ __forceinline__ void conv_unit(Frame& F, int l, int unit, const float (&wj)[CK], const ConvRegs& R) {
    refresh(F);
    const int row0 = unit * CT, pos0 = row0 & (SEQ - 1), c = F.tid;
    bf16_t* Y = (bf16_t*)(F.ws + WS_BIG + BO_Y);
    LAS bf16_t* H = (LAS bf16_t*)F.lds;
    LAS float* CV = (LAS float*)(F.lds + CR * 512 * 2);
    {
        constexpr int NP = CONV_NP, NK = CONV_NK;
        const u32x4 (&cv)[NK] = R.cv; const u32x4 (&cg)[NK] = R.cg;
#pragma unroll
        for (int k = 0; k < NK; ++k) { const int p = c + 512 * k; if (p < NP) { const int i = p >> 6, grp = p & 63; const float ok = (pos0 - (CK - 1) + i) >= 0 ? 1.f : 0.f;
            u32x4 o;
            o.x = cvt_pk_bf16(ok * bf_lo(cv[k].x) * fast_sigmoid(bf_lo(cg[k].x)), ok * bf_hi(cv[k].x) * fast_sigmoid(bf_hi(cg[k].x)));
            o.y = cvt_pk_bf16(ok * bf_lo(cv[k].y) * fast_sigmoid(bf_lo(cg[k].y)), ok * bf_hi(cv[k].y) * fast_sigmoid(bf_hi(cg[k].y)));
            o.z = cvt_pk_bf16(ok * bf_lo(cv[k].z) * fast_sigmoid(bf_lo(cg[k].z)), ok * bf_hi(cv[k].z) * fast_sigmoid(bf_hi(cg[k].z)));
            o.w = cvt_pk_bf16(ok * bf_lo(cv[k].w) * fast_sigmoid(bf_lo(cg[k].w)), ok * bf_hi(cv[k].w) * fast_sigmoid(bf_hi(cg[k].w)));
            *(LAS u32x4*)(H + i * 512 + 8 * grp) = o; } }
    }
    __syncthreads();
    float acc[CT];
#pragma unroll
    for (int t = 0; t < CT; ++t) acc[t] = 0.f;
    conv_taps<0>(acc, wj, H + c);
    const float bd = inp(F, 12)[l * CW + c];
#pragma unroll
    for (int t = 0; t < CT; ++t) CV[t * 512 + c] = acc[t] + bd;
    __syncthreads();
    const GAS f32x4* lg = (const GAS f32x4*)(inp(F, 13) + l * CW) + 2 * F.lane; const GAS f32x4* lb = (const GAS f32x4*)(inp(F, 14) + l * CW) + 2 * F.lane;
    const f32x4 g0 = lg[0], g1 = lg[1], b0 = lb[0], b1 = lb[1];
#pragma unroll
    for (int k = 0; k < CT / 8; ++k) { const int t = (CT / 8) * F.wave + k;
        f32x4 a = *(const LAS f32x4*)(CV + t * 512 + 8 * F.lane), b = *(const LAS f32x4*)(CV + t * 512 + 8 * F.lane + 4);
        const float mu = wave_sum((a.x + a.y) + (a.z + a.w) + (b.x + b.y) + (b.z + b.w)) * (1.f / CW);
        a = a - mu; b = b - mu;
        const float var = wave_sum((a.x * a.x + a.y * a.y) + (a.z * a.z + a.w * a.w) + (b.x * b.x + b.y * b.y) + (b.z * b.z + b.w * b.w)) * (1.f / CW);
        const float rs = 1.f / sqrtf(var + LN_EPS);
        a = a * rs * g0 + b0; b = b * rs * g1 + b1;
        u32x4 o; o.x = cvt_pk_bf16(a.x * fast_sigmoid(a.x), a.y * fast_sigmoid(a.y)); o.y = cvt_pk_bf16(a.z * fast_sigmoid(a.z), a.w * fast_sigmoid(a.w));
        o.z = cvt_pk_bf16(b.x * fast_sigmoid(b.x), b.y * fast_sigmoid(b.y)); o.w = cvt_pk_bf16(b.z * fast_sigmoid(b.z), b.w * fast_sigmoid(b.w));
        *(GAS u32x4*)(Y + (size_t)(row0 + t) * D + GW + PW + 8 * F.lane) = o; }
    __syncthreads();
}
static_assert((M / CH) * GH / 2 == 256 && (M / CH) * PG == 256 && M / CT == 256, "the three mixers have 256 units each");
__device__ __forceinline__ void mixer_phase(Frame& F, int l) {
    float wj[CK]; { const float* wdw = inp(F, 11) + (size_t)l * CK * CW + fresh_tid();
#pragma unroll
        for (int j = 0; j < CK; ++j) wj[j] = wdw[j * CW]; }
    for (int u = F.vcu; u < 256; u += F.G) {
        PoolRegs PR; pool_load(F, l, u, PR);
        gmlp_pair(F, l, u);
        ConvRegs CRg; conv_load(F, u, CRg);
        pool_unit(F, l, u, PR);
        conv_unit(F, l, u, wj, CRg);
    }
}

struct Args { const float* in[26]; float* out; unsigned char* ws; int stop, rep; };
__global__ void __launch_bounds__(NWAVES * 64, 2) mega_fwd(Args args) {
    extern __shared__ __attribute__((aligned(16))) unsigned char lds[];
    Frame F;
    F.lds = (LAS unsigned char*)lds;
    F.tid = threadIdx.x; F.lane = F.tid & 63; F.wave = __builtin_amdgcn_readfirstlane(F.tid >> 6);
    F.G = gridDim.x; { const int bx = blockIdx.x; F.vcu = (F.G % 8 == 0) ? (bx % 8) * (F.G / 8) + bx / 8 : bx; }
    F.kp = __builtin_amdgcn_kernarg_segment_ptr();
    F.xg = (F.G == 256) ? (F.vcu >> 5) : -1; F.local = false;
    F.out = args.out; F.ws = args.ws;
    for (int u = F.tid; u < (LDS_BYTES - LDSCTL_OFF) / 4; u += NWAVES * 64) ((LAS unsigned*)(F.lds + LDSCTL_OFF))[u] = 0u;
    __syncthreads();
    const XcdBarrier bar = xcd_barrier_post((unsigned*)(F.ws + WS_CTL) + CW_BAR, (volatile LAS unsigned*)(F.lds + MISC_OFF) + 8);
#define GRID_BAR() do { xcd_barrier(bar); if (++ph >= args.stop) return; } while (0)
#define GRID_BAR_CONV(nowb, slot) do { if (l == 0 && F.G == 256) xcd_barrier_conv(bar, (nowb) && F.local, F, U_LAYER + (slot) * 1792, U_LAYER + U_EARLY); else xcd_barrier(bar, (nowb) && F.local); if (++ph >= args.stop) return; } while (0)
#define GRID_BAR_LOCAL() do { xcd_barrier(bar, F.local); if (++ph >= args.stop) return; } while (0)
    int ph = 0;
    const int cid0 = (int)blockIdx.x;
#define cid opaque_s(cid0)
#define sc opaque_s((F.xg >= 0) ? (F.vcu & 31) : cid0)
    const char* XN = (const char*)(F.ws + WS_XN); float* HB = (float*)(F.ws + WS_HB);
    unsigned char* BIG = F.ws + WS_BIG;

    if (F.xg >= 0 && F.tid == 0) __hip_atomic_store((unsigned*)(F.ws + WS_CTL) + CW_XCC + cid0, xb_xcc_id() + 1u, __ATOMIC_RELAXED, __HIP_MEMORY_SCOPE_AGENT);
    for (int r_ = 0; r_ < (args.rep == 0 ? 2 : 1); ++r_) p0_prologue(F);
    if (args.rep == 100) for (int r_ = 0; r_ < 50; ++r_) xcd_barrier(bar);
    if (F.G == 256) { xcd_barrier_conv(bar, false, F, U_PB0, U_PB1); if (++ph >= args.stop) return; } else GRID_BAR();
    if (F.xg >= 0) {
        refresh(F); LAS unsigned* okw = (LAS unsigned*)(F.lds + MISC_OFF) + 16;
        if (F.tid < 256) { const unsigned mine = __hip_atomic_load((unsigned*)(F.ws + WS_CTL) + CW_XCC + F.tid, __ATOMIC_RELAXED, __HIP_MEMORY_SCOPE_AGENT), lead = __hip_atomic_load((unsigned*)(F.ws + WS_CTL) + CW_XCC + (F.tid & 7), __ATOMIC_RELAXED, __HIP_MEMORY_SCOPE_AGENT);
            const bool ok = __all(mine != 0u && mine == lead); if (F.lane == 0) okw[F.wave] = ok ? 1u : 0u; }
        LDS_WAIT(); __syncthreads();
        F.local = (okw[0] & okw[1] & okw[2] & okw[3]) != 0u;
        __syncthreads();
    }
    for (int l = 0; l < NL; ++l) {
        const unsigned char* wl = F.ws + WS_W + (size_t)l * W_LAYER;
        const char* MN = (const char*)(F.ws + WS_MN) + (size_t)l * MM * D * 2;
        for (int r_ = 0; r_ < (args.rep == 1 ? 2 : 1); ++r_)
        { SchedIn S{(const char*)F.ws, (const char*)wl, MN, F.G, sc, F.xg};
          pg8::gemm_phase<pg8::EpiBf16<1>, SchedIn>(F.lds, D, D, S, pg8::EpiBf16<1>{}); }
        if (l == 0 && F.G == 256) { xcd_barrier_conv(bar, false, F, U_PB1, U_WO1, U_WOUT1 - U_PB1, U_WO0); if (++ph >= args.stop) return; } else GRID_BAR();
        for (int r_ = 0; r_ < (args.rep == 2 ? 2 : 1); ++r_) mixer_phase(F, l);
        GRID_BAR_CONV(l != 0 || F.G != 256, 0);
        for (int r_ = 0; r_ < (args.rep == 3 ? 2 : 1); ++r_)
        { SchedGU S{(const char*)F.ws, (const char*)wl, F.G, sc, F.xg}; pg8::gemm_phase<pg8::EpiBf16<0>, SchedGU>(F.lds, D, D, S, pg8::EpiBf16<0>{}); }
        GRID_BAR_CONV(false, 1);
        norm_pass<false, false>(F, inp(F, 3) + l * D, inp(F, 15) + l * D, inp(F, 2) + l * D);
        GRID_BAR_CONV(true, 2);
        for (int r_ = 0; r_ < (args.rep == 6 ? 2 : 1); ++r_) {
        { SchedS S{XN, (const char*)(BIG + BO_GT), BIG + BO_P, F.G, sc, F.xg};
          pg8::gemm_phase<pg8::EpiSoftmax, SchedS>(F.lds, D, D, S, pg8::EpiSoftmax{0.044194173824159216f * 1.44269504089f}); }
        if (F.G == 256) {
            refresh(F); const int lo = l * U_LAYER + U_EARLY, mid = lo + (l == 0 ? U_IDLE_SHARE : U_IDLE_SHARE_L1), hi = (l + 1) * U_LAYER;
            if (cid0 >= 128) { p0_convert(F, (cid0 - 128) * NWAVES + F.wave, 128 * NWAVES, lo, mid); }
            else { __syncthreads();   p0_convert(F, cid0 * NWAVES + F.wave, 128 * NWAVES, mid, hi); } }
        }
        if (l == 0 && F.G == 256) { xcd_barrier_plain(bar, false, F, 1, 0, D * D / 16); if (++ph >= args.stop) return; } else GRID_BAR();
        for (int r_ = 0; r_ < (args.rep == 8 ? 2 : 1); ++r_)
        { SchedO S{(const char*)(BIG + BO_P), (const char*)(BIG + BO_UT), HB, F.G, sc, F.xg};
          pg8::gemm_phase<pg8::EpiBf16<0>, SchedO>(F.lds, XH * MEM, XH * MEM, S, pg8::EpiBf16<0>{}); }
        GRID_BAR_CONV(true, 3);
        norm_pass<false, false>(F, inp(F, 17) + l * D, inp(F, 22) + l * D, inp(F, 15) + l * D);
        GRID_BAR_CONV(true, 4);
        for (int r_ = 0; r_ < (args.rep == 10 ? 2 : 1); ++r_)
        { typedef SchedPlain<D, D, FF, M / 256, FF / 256, D> SP; SP S{XN, (const char*)(wl + WO_UP), BIG + BO_UP, F.G, sc, F.xg};
          pg8::gemm_phase<pg8::EpiBf16<2>, SP>(F.lds, D, D, S, pg8::EpiBf16<2>{}); }
        GRID_BAR_CONV(true, 5);
        for (int r_ = 0; r_ < (args.rep == 11 ? 2 : 1); ++r_)
        { typedef SchedPlain<FF, FF, D, M / 256, D / 256, FF> SP; SP S{(const char*)(BIG + BO_UP), (const char*)(wl + WO_DN), HB, F.G, sc, F.xg};
          pg8::gemm_phase<pg8::EpiBf16<0>, SP>(F.lds, FF, FF, S, pg8::EpiBf16<0>{}); }
        GRID_BAR_CONV(true, 6);
        if (l + 1 < NL) norm_pass<false, false>(F, inp(F, 23) + l * D, inp(F, 2) + (l + 1) * D, inp(F, 22) + l * D); else norm_pass<false, true>(F, inp(F, 23) + l * D, nullptr, inp(F, 22) + l * D);
        if (l + 1 < NL) { if (l == 0 && F.G == 256) { xcd_barrier_plain(bar, false, F, 1, D * D / 16, D * D / 8); if (++ph >= args.stop) return; } else GRID_BAR(); }
    }
}


#ifndef DBG_CUT
#define DBG_CUT 6
#endif
#ifndef PROBE_REP
#define PROBE_REP -1
#endif
#if DBG_CUT < 6
namespace nv {
constexpr int D = 2048, B = 4, S = 2048, L = 2, MEM = 256, HD = 128, CH = 128;
constexpr int GW = 1024, PW = 512, CW = 512, NIN = 3584, GH = 8, PG = 4, CK = 31, XH = 4, XD = 512, FF = 8192;
constexpr int M = B * S, MM = B * MEM;
constexpr float RMS_EPS = 1e-6f, LN_EPS = 1e-5f;

__device__ __forceinline__ float gelu_tanh(float x) { const float u = 0.7978845608028654f * (x + 0.044715f * x * x * x); return 0.5f * x * (1.f + tanhf(u)); }
__device__ __forceinline__ float sigmoidf(float x) { return 1.f / (1.f + expf(-x)); }

__device__ __forceinline__ float block_sum(float v, float* red) {
    for (int o = 32; o > 0; o >>= 1) v += __shfl_xor(v, o);
    __syncthreads();
    if ((threadIdx.x & 63) == 0) red[threadIdx.x >> 6] = v;
    __syncthreads();
    float s = 0.f; for (int i = 0; i < (int)(blockDim.x >> 6); ++i) s += red[i];
    return s;
}

template <int ACC> __global__ void __launch_bounds__(256) k_rmsnorm(const float* in, const float* g, float* out, int ncols) {
    __shared__ float red[8];
    const float* r = in + (size_t)blockIdx.x * ncols; float* o = out + (size_t)blockIdx.x * ncols;
    float s = 0.f; for (int c = threadIdx.x; c < ncols; c += 256) { const float v = r[c]; s += v * v; }
    s = block_sum(s, red);
    const float rs = rsqrtf(s / ncols + RMS_EPS);
    for (int c = threadIdx.x; c < ncols; c += 256) { const float v = r[c] * rs * g[c]; if (ACC) o[c] += v; else o[c] = v; }
}

template <int EPI> __global__ void __launch_bounds__(256) k_gemm(const float* A, const float* Bm, float* C, int Mr, int N, int K, int ngelu) {
    __shared__ float As[16][65], Bs[16][65];
    const int tx = threadIdx.x & 15, ty = threadIdx.x >> 4, m0 = blockIdx.y * 64, n0 = blockIdx.x * 64;
    float acc[4][4] = {};
    for (int k0 = 0; k0 < K; k0 += 16) {
        for (int i = threadIdx.x; i < 1024; i += 256) { const int r = i >> 4, c = i & 15; As[c][r] = A[(size_t)(m0 + r) * K + k0 + c]; }
        for (int i = threadIdx.x; i < 1024; i += 256) { const int r = i >> 6, c = i & 63; Bs[r][c] = Bm[(size_t)(k0 + r) * N + n0 + c]; }
        __syncthreads();
#pragma unroll
        for (int kk = 0; kk < 16; ++kk) {
            float a[4], b[4];
#pragma unroll
            for (int i = 0; i < 4; ++i) { a[i] = As[kk][ty * 4 + i]; b[i] = Bs[kk][tx * 4 + i]; }
#pragma unroll
            for (int i = 0; i < 4; ++i)
#pragma unroll
                for (int j = 0; j < 4; ++j) acc[i][j] += a[i] * b[j];
        }
        __syncthreads();
    }
#pragma unroll
    for (int i = 0; i < 4; ++i)
#pragma unroll
        for (int j = 0; j < 4; ++j) {
            const int r = m0 + ty * 4 + i, c = n0 + tx * 4 + j; float v = acc[i][j];
            if (EPI == 1) { if (c < ngelu) v = gelu_tanh(v); }
            if (EPI == 2) { v = v > 0.f ? v * v : 0.f; }
            C[(size_t)r * N + c] = v;
        }
}

__global__ void __launch_bounds__(256) k_gmlp(const float* z, const float* gv, const float* ws, const float* bs, float* y) {
    __shared__ float v[128][129];
    const int cb = blockIdx.x, h = blockIdx.y, row0 = cb * CH, tid = threadIdx.x;
    for (int i = tid; i < 128 * 128; i += 256) { const int s = i >> 7, d = i & 127; v[s][d] = z[(size_t)(row0 + s) * NIN + GW + h * HD + d]; }
    __syncthreads();
    if (tid < 128) {
        float mu = 0.f; for (int d = 0; d < 128; ++d) mu += v[tid][d]; mu *= (1.f / 128.f);
        float var = 0.f; for (int d = 0; d < 128; ++d) { const float e = v[tid][d] - mu; var += e * e; } var *= (1.f / 128.f);
        const float rs = rsqrtf(var + LN_EPS);
        for (int d = 0; d < 128; ++d) v[tid][d] = (v[tid][d] - mu) * rs * gv[h * HD + d];
    }
    __syncthreads();
    const int d = tid & 127, th = tid >> 7;
    for (int t = th * 64; t < th * 64 + 64; ++t) {
        const float* w = ws + ((size_t)h * CH + t) * CH; float acc = 0.f;
        for (int s = 0; s <= t; ++s) acc += w[s] * v[s][d];
        acc += bs[h * CH + t];
        const size_t r = (size_t)(row0 + t);
        y[r * D + h * HD + d] = z[r * NIN + h * HD + d] * acc;
    }
}

__global__ void __launch_bounds__(256) k_pool(const float* z, const float* wp, const float* sp, float* y) {
    __shared__ float pl[64][129];
    const int tb = blockIdx.x, g = blockIdx.y, row0 = tb * 64, tid = threadIdx.x;
    const int wins[4] = {2, 4, 8, 16}; const int w = wins[g];
    for (int i = tid; i < 64 * 128; i += 256) {
        const int tt = i >> 7, c = i & 127, row = row0 + tt, t = row % S;
        float sum = 0.f; const int lo = (t - w + 1) < 0 ? 0 : (t - w + 1);
        for (int s = lo; s <= t; ++s) sum += z[(size_t)(row - t + s) * NIN + 2 * GW + g * 128 + c];
        const float cnt = (float)((t + 1) < w ? (t + 1) : w);
        pl[tt][c] = sum / cnt - z[(size_t)row * NIN + 2 * GW + g * 128 + c];
    }
    __syncthreads();
    const int d = tid & 127, th = tid >> 7;
    for (int tt = th * 32; tt < th * 32 + 32; ++tt) {
        float acc = 0.f; for (int c = 0; c < 128; ++c) acc += pl[tt][c] * wp[((size_t)g * 128 + c) * 128 + d];
        y[(size_t)(row0 + tt) * D + GW + g * 128 + d] = acc * sp[g * 128 + d];
    }
}

__global__ void __launch_bounds__(512) k_conv(const float* z, const float* wdw, const float* bdw, const float* lg, const float* lb, float* y) {
    __shared__ float red[8];
    const int row = blockIdx.x, t = row % S, c = threadIdx.x;
    float acc = 0.f;
    for (int j = 0; j < CK; ++j) { const int ts = t + j - (CK - 1); if (ts < 0) continue; const size_t r = (size_t)(row - t + ts);
        const float cv = z[r * NIN + 2 * GW + PW + c], cg = z[r * NIN + 2 * GW + PW + CW + c]; acc += wdw[j * CW + c] * (cv * sigmoidf(cg)); }
    acc += bdw[c];
    float s = acc; for (int o = 32; o > 0; o >>= 1) s += __shfl_xor(s, o);
    if ((c & 63) == 0) red[c >> 6] = s; __syncthreads();
    float mu = 0.f; for (int i = 0; i < 8; ++i) mu += red[i]; mu *= (1.f / 512.f);
    __syncthreads();
    const float e = acc - mu; float q = e * e; for (int o = 32; o > 0; o >>= 1) q += __shfl_xor(q, o);
    if ((c & 63) == 0) red[c >> 6] = q; __syncthreads();
    float var = 0.f; for (int i = 0; i < 8; ++i) var += red[i]; var *= (1.f / 512.f);
    const float ln = e * rsqrtf(var + LN_EPS) * lg[c] + lb[c];
    y[(size_t)row * D + GW + PW + c] = ln * sigmoidf(ln);
}

__global__ void __launch_bounds__(256) k_attn(const float* q, const float* kk, const float* vv, float* o) {
    __shared__ float qs[512], p[256], red[8];
    const int row = blockIdx.x, h = blockIdx.y, b = row / S, j = threadIdx.x;
    qs[j] = q[(size_t)row * D + h * XD + j]; qs[j + 256] = q[(size_t)row * D + h * XD + 256 + j];
    __syncthreads();
    const float* kr = kk + (size_t)(b * MEM + j) * D + h * XD; float sc = 0.f;
    for (int d = 0; d < XD; ++d) sc += qs[d] * kr[d];
    sc *= 0.044194173824159216f;
    float mx = sc; for (int o2 = 32; o2 > 0; o2 >>= 1) mx = fmaxf(mx, __shfl_xor(mx, o2));
    if ((j & 63) == 0) red[j >> 6] = mx; __syncthreads();
    mx = fmaxf(fmaxf(red[0], red[1]), fmaxf(red[2], red[3])); __syncthreads();
    const float e = expf(sc - mx); float sm = e; for (int o2 = 32; o2 > 0; o2 >>= 1) sm += __shfl_xor(sm, o2);
    if ((j & 63) == 0) red[j >> 6] = sm; __syncthreads();
    sm = red[0] + red[1] + red[2] + red[3];
    p[j] = e / sm; __syncthreads();
    for (int d = j; d < XD; d += 256) { float acc = 0.f; for (int m = 0; m < MEM; ++m) acc += p[m] * vv[(size_t)(b * MEM + m) * D + h * XD + d]; o[(size_t)row * D + h * XD + d] = acc; }
}
}
__global__ void k_bf2f(const unsigned short* in, float* out, size_t n) { size_t i = (size_t)blockIdx.x * 256 + threadIdx.x; if (i < n) out[i] = __builtin_bit_cast(float, (unsigned)in[i] << 16); }
__global__ void k_bf2f_t(const unsigned short* in, float* out, int R, int C) {
    size_t i = (size_t)blockIdx.x * 256 + threadIdx.x; if (i < (size_t)R * C) { const int r = i / C, c = i % C; out[(size_t)c * R + r] = __builtin_bit_cast(float, (unsigned)in[i] << 16); } }
__global__ void k_bf2f_cols(const unsigned short* in, float* out, int R, int C, int c0, int c1) {
    size_t i = (size_t)blockIdx.x * 256 + threadIdx.x; const int w = c1 - c0; if (i < (size_t)R * w) { const int r = i / w, c = c0 + i % w; out[(size_t)r * C + c] = __builtin_bit_cast(float, (unsigned)in[(size_t)r * C + c] << 16); } }
#ifndef DBG_MODE
#define DBG_MODE 7
#endif
static void naive_from(void* const* d_in, void* d_out, void* d_ws, hipStream_t stream, int from) {
    using nv::k_rmsnorm; using nv::k_gemm; using nv::k_gmlp; using nv::k_pool; using nv::k_conv; using nv::k_attn;
    const float* mem = (const float*)d_in[1];
    const float *n_mix_pre = (const float*)d_in[2], *n_mix_post = (const float*)d_in[3], *w_in = (const float*)d_in[4], *w_out = (const float*)d_in[5], *g_v = (const float*)d_in[6],
                *w_sp = (const float*)d_in[7], *b_sp = (const float*)d_in[8], *w_pool = (const float*)d_in[9], *s_pool = (const float*)d_in[10], *w_dw = (const float*)d_in[11], *b_dw = (const float*)d_in[12],
                *cln_g = (const float*)d_in[13], *cln_b = (const float*)d_in[14], *n_xa_pre = (const float*)d_in[15], *n_mem = (const float*)d_in[16], *n_xa_post = (const float*)d_in[17],
                *w_q = (const float*)d_in[18], *w_k = (const float*)d_in[19], *w_v = (const float*)d_in[20], *w_o = (const float*)d_in[21], *n_ffn_pre = (const float*)d_in[22], *n_ffn_post = (const float*)d_in[23],
                *w_up = (const float*)d_in[24], *w_down = (const float*)d_in[25];
    float* xr = (float*)d_out;
    const size_t MD = (size_t)nv::M * nv::D;
    float* ws = (float*)d_ws;
    float* hn = ws; float* hb = hn + MD; float* mn = hb + MD; float* kk = mn + (size_t)nv::MM * nv::D; float* vv = kk + (size_t)nv::MM * nv::D; float* big = vv + (size_t)nv::MM * nv::D;
    float* z = big; float* y = big + (size_t)nv::M * nv::NIN; float* q = big; float* o = big + MD; float* up = big;
    const unsigned char* mws = (const unsigned char*)d_ws;
    if (DBG_MODE == 1 || DBG_MODE == 2 || (DBG_MODE >= 5 && DBG_MODE <= 7)) {
        const int l = 0;
        if (DBG_MODE != 2) {
            k_bf2f<<<(unsigned)(((size_t)nv::M * nv::NIN + 255) / 256), 256, 0, stream>>>((const unsigned short*)(mws + WS_BIG + BO_Z), z, (size_t)nv::M * nv::NIN);
            k_gmlp<<<dim3(nv::M / nv::CH, nv::GH), 256, 0, stream>>>(z, g_v + l * nv::GH * nv::HD, w_sp + (size_t)l * nv::GH * nv::CH * nv::CH, b_sp + l * nv::GH * nv::CH, y);
            k_pool<<<dim3(nv::M / 64, nv::PG), 256, 0, stream>>>(z, w_pool + (size_t)l * nv::PG * 128 * 128, s_pool + l * nv::PW, y);
            k_conv<<<nv::M, 512, 0, stream>>>(z, w_dw + (size_t)l * nv::CK * nv::CW, b_dw + l * nv::CW, cln_g + l * nv::CW, cln_b + l * nv::CW, y);
            if (DBG_MODE >= 5) { const int c0 = DBG_MODE == 5 ? 0 : (DBG_MODE == 6 ? 1024 : 1536), c1 = DBG_MODE == 5 ? 1024 : (DBG_MODE == 6 ? 1536 : 2048);
                k_bf2f_cols<<<(unsigned)(((size_t)nv::M * (c1 - c0) + 255) / 256), 256, 0, stream>>>((const unsigned short*)(mws + WS_BIG + BO_Y), y, nv::M, nv::D, c0, c1); }
        } else {
            k_bf2f<<<(unsigned)((MD + 255) / 256), 256, 0, stream>>>((const unsigned short*)(mws + WS_BIG + BO_Y), y, MD);
        }
        k_gemm<0><<<dim3(nv::D / 64, nv::M / 64), 256, 0, stream>>>(y, w_out + (size_t)l * nv::D * nv::D, hb, nv::M, nv::D, nv::D, 0);
        k_rmsnorm<1><<<nv::M, 256, 0, stream>>>(hb, n_mix_post + l * nv::D, xr, nv::D);
    }
    if (DBG_MODE == 3 || DBG_MODE == 4) {
        const int l = 0;
        if (DBG_MODE == 3) {
            k_bf2f<<<(unsigned)((MD + 255) / 256), 256, 0, stream>>>((const unsigned short*)(mws + WS_BIG + BO_Q), q, MD);
            k_bf2f<<<(unsigned)(((size_t)nv::MM * nv::D + 255) / 256), 256, 0, stream>>>((const unsigned short*)(mws + WS_KB), kk, (size_t)nv::MM * nv::D);
            k_bf2f_t<<<(unsigned)(((size_t)nv::MM * nv::D + 255) / 256), 256, 0, stream>>>((const unsigned short*)(mws + WS_VT), vv, nv::D, nv::MM);
            k_attn<<<dim3(nv::M, nv::XH), 256, 0, stream>>>(q, kk, vv, o);
        } else {
            k_bf2f<<<(unsigned)((MD + 255) / 256), 256, 0, stream>>>((const unsigned short*)(mws + WS_BIG + BO_O), o, MD);
        }
        k_gemm<0><<<dim3(nv::D / 64, nv::M / 64), 256, 0, stream>>>(o, w_o + (size_t)l * nv::D * nv::D, hb, nv::M, nv::D, nv::D, 0);
        k_rmsnorm<1><<<nv::M, 256, 0, stream>>>(hb, n_xa_post + l * nv::D, xr, nv::D);
    }
    for (int sl = from; sl < 6; ++sl) {
        const int l = sl / 3, k = sl % 3;
        if (k == 0) {
            k_rmsnorm<0><<<nv::M, 256, 0, stream>>>(xr, n_mix_pre + l * nv::D, hn, nv::D);
            k_gemm<1><<<dim3(nv::NIN / 64, nv::M / 64), 256, 0, stream>>>(hn, w_in + (size_t)l * nv::D * nv::NIN, z, nv::M, nv::NIN, nv::D, 2 * nv::GW);
            k_gmlp<<<dim3(nv::M / nv::CH, nv::GH), 256, 0, stream>>>(z, g_v + l * nv::GH * nv::HD, w_sp + (size_t)l * nv::GH * nv::CH * nv::CH, b_sp + l * nv::GH * nv::CH, y);
            k_pool<<<dim3(nv::M / 64, nv::PG), 256, 0, stream>>>(z, w_pool + (size_t)l * nv::PG * 128 * 128, s_pool + l * nv::PW, y);
            k_conv<<<nv::M, 512, 0, stream>>>(z, w_dw + (size_t)l * nv::CK * nv::CW, b_dw + l * nv::CW, cln_g + l * nv::CW, cln_b + l * nv::CW, y);
            k_gemm<0><<<dim3(nv::D / 64, nv::M / 64), 256, 0, stream>>>(y, w_out + (size_t)l * nv::D * nv::D, hb, nv::M, nv::D, nv::D, 0);
            k_rmsnorm<1><<<nv::M, 256, 0, stream>>>(hb, n_mix_post + l * nv::D, xr, nv::D);
        } else if (k == 1) {
            k_rmsnorm<0><<<nv::M, 256, 0, stream>>>(xr, n_xa_pre + l * nv::D, hn, nv::D);
            k_rmsnorm<0><<<nv::MM, 256, 0, stream>>>(mem, n_mem + l * nv::D, mn, nv::D);
            k_gemm<0><<<dim3(nv::D / 64, nv::M / 64), 256, 0, stream>>>(hn, w_q + (size_t)l * nv::D * nv::D, q, nv::M, nv::D, nv::D, 0);
            k_gemm<0><<<dim3(nv::D / 64, nv::MM / 64), 256, 0, stream>>>(mn, w_k + (size_t)l * nv::D * nv::D, kk, nv::MM, nv::D, nv::D, 0);
            k_gemm<0><<<dim3(nv::D / 64, nv::MM / 64), 256, 0, stream>>>(mn, w_v + (size_t)l * nv::D * nv::D, vv, nv::MM, nv::D, nv::D, 0);
            k_attn<<<dim3(nv::M, nv::XH), 256, 0, stream>>>(q, kk, vv, o);
            k_gemm<0><<<dim3(nv::D / 64, nv::M / 64), 256, 0, stream>>>(o, w_o + (size_t)l * nv::D * nv::D, hb, nv::M, nv::D, nv::D, 0);
            k_rmsnorm<1><<<nv::M, 256, 0, stream>>>(hb, n_xa_post + l * nv::D, xr, nv::D);
        } else {
            k_rmsnorm<0><<<nv::M, 256, 0, stream>>>(xr, n_ffn_pre + l * nv::D, hn, nv::D);
            k_gemm<2><<<dim3(nv::FF / 64, nv::M / 64), 256, 0, stream>>>(hn, w_up + (size_t)l * nv::D * nv::FF, up, nv::M, nv::FF, nv::D, 0);
            k_gemm<0><<<dim3(nv::D / 64, nv::M / 64), 256, 0, stream>>>(up, w_down + (size_t)l * nv::FF * nv::D, hb, nv::M, nv::D, nv::FF, 0);
            k_rmsnorm<1><<<nv::M, 256, 0, stream>>>(hb, n_ffn_post + l * nv::D, xr, nv::D);
        }
    }
}
#endif

extern "C" void kernel_launch(void* const* d_in, const int* in_sizes, int n_in, void* d_out, int out_size, void* d_ws, size_t ws_size, hipStream_t stream) {
    static int grid = 0;
    if (grid == 0) {
        if (n_in != 26 || in_sizes[0] != M * D || out_size != M * D || ws_size < WS_END) { fprintf(stderr, "kernel_launch: unexpected shapes (n_in %d, in0 %d, out %d, ws %zu < %zu); nothing launched\n", n_in, n_in > 0 ? in_sizes[0] : -1, out_size, ws_size, (size_t)WS_END); grid = -1; return; }
        int dev = 0, cus = 0, per_cu = 0;
        if (hipGetDevice(&dev) != hipSuccess || hipDeviceGetAttribute(&cus, hipDeviceAttributeMultiprocessorCount, dev) != hipSuccess) { grid = -1; return; }
        if (hipFuncSetAttribute((const void*)mega_fwd, hipFuncAttributeMaxDynamicSharedMemorySize, LDS_BYTES) != hipSuccess) { fprintf(stderr, "kernel_launch: hipFuncSetAttribute failed\n"); grid = -1; return; }
        if (hipOccupancyMaxActiveBlocksPerMultiprocessor(&per_cu, (const void*)mega_fwd, NWAVES * 64, LDS_BYTES) != hipSuccess || per_cu < 1) { fprintf(stderr, "kernel_launch: occupancy query says %d blocks per CU\n", per_cu); per_cu = 1; }
        (void)hipGetLastError();
        grid = cus * 1;
    }
    if (grid < 0) return;
    if (hipMemsetAsync((char*)d_ws + WS_CTL, 0, CTL_ZERO_BYTES, stream) != hipSuccess) { fprintf(stderr, "kernel_launch: memset failed\n"); return; }
    Args a{};
    for (int i = 0; i < 26; ++i) a.in[i] = (const float*)d_in[i];
    a.out = (float*)d_out; a.ws = (unsigned char*)d_ws;
    a.rep = PROBE_REP;
    { const int stops[7] = {1, 5, 8, 11, 15, 18, 1000}; a.stop = stops[DBG_CUT]; }
#if DBG_CUT < 6
    if (DBG_MODE == 1) a.stop = 2; if (DBG_MODE == 2 || DBG_MODE >= 5) a.stop = 3; if (DBG_MODE == 3) a.stop = 6; if (DBG_MODE == 4) a.stop = 8;
#endif
    void* kargs[] = {&a};
    hipError_t e = hipLaunchCooperativeKernel((const void*)mega_fwd, dim3(grid), dim3(NWAVES * 64), kargs, LDS_BYTES, stream);
    if (e != hipSuccess) fprintf(stderr, "kernel_launch: cooperative launch failed: %s (grid %d)\n", hipGetErrorString(e), grid);
#if DBG_CUT < 6
    naive_from(d_in, d_out, d_ws, stream, DBG_CUT);
#endif
}
```
